# Optimizing an MI355X kernel written in HIP

```python
import math
import jax
import jax.numpy as jnp
from jax import lax
import numpy as np

D_MODEL = 1024
BATCH = 8
SEQ = 4096
DEPTH = 4

GRID_W = 64
CTX_LEN = 256
EPS = 1e-6

DA_HEADS = 4
DA_HEAD_DIM = 64
DA_V_DIM = 2 * DA_HEAD_DIM
DA_WIDTH = DA_HEADS * 2 * DA_HEAD_DIM
ROPE_AXIS_DIM = DA_HEAD_DIM // 2
ROPE_THETA = 10000.0
Q_BLOCK = 128

CM_CHUNK = 128
CM_GROUPS = 4
CM_WIDTH = 512
CM_GROUP_W = CM_WIDTH // CM_GROUPS

FN_GROUPS = 4
FN_WIDTH = 512
FN_GROUP_W = FN_WIDTH // FN_GROUPS

N_BRANCH = 3
BRANCH_W = 512
SPLIT_POINTS = [DA_WIDTH, 2 * DA_WIDTH, 3 * DA_WIDTH, 3 * DA_WIDTH + CM_WIDTH,
                3 * DA_WIDTH + 2 * CM_WIDTH, 3 * DA_WIDTH + 2 * CM_WIDTH + FN_WIDTH]
IN_COLS = SPLIT_POINTS[-1] + N_BRANCH * D_MODEL

PEER_HEADS = 8
PEER_KEYS = 128
PEER_EXPERTS = PEER_KEYS * PEER_KEYS
PEER_QDIM = 256
PEER_HALF = PEER_QDIM // 2
PEER_TOPK = 16
PEER_TOKEN_BLOCK = 128

kernel_name = 'hybrid_diffattn_chunkmlp_fourier_peer_dit'

F32 = jnp.float32


def rmsnorm(x, g):
    xf = x.astype(F32)
    y = xf * lax.rsqrt(jnp.mean(xf * xf, axis=-1, keepdims=True) + EPS)
    return (y * g.astype(F32)).astype(x.dtype)


def rms_unit(x):
    xf = x.astype(F32)
    return (xf * lax.rsqrt(jnp.mean(xf * xf, axis=-1, keepdims=True) + EPS)).astype(x.dtype)


def layernorm(x, g):
    xf = x.astype(F32)
    mu = jnp.mean(xf, axis=-1, keepdims=True)
    var = jnp.mean(jnp.square(xf - mu), axis=-1, keepdims=True)
    return ((xf - mu) * lax.rsqrt(var + EPS) * g.astype(F32)).astype(x.dtype)


def modulate(x, shift, scale):
    return x * (1 + scale) + shift


def axial_angles(rows):
    r, col = jnp.meshgrid(jnp.arange(rows, dtype=F32), jnp.arange(GRID_W, dtype=F32), indexing='ij')
    freqs = ROPE_THETA ** (-jnp.arange(0, ROPE_AXIS_DIM, 2, dtype=F32) / ROPE_AXIS_DIM)
    ang_r = r.reshape(-1, 1) * freqs
    ang_c = col.reshape(-1, 1) * freqs
    return ang_r[:, None, None, :], ang_c[:, None, None, :]


def rope_axis(xp, ang):
    x1, x2 = jnp.split(xp, 2, axis=-1)
    cos, sin = jnp.cos(ang), jnp.sin(ang)
    return jnp.concatenate([x1 * cos - x2 * sin, x2 * cos + x1 * sin], axis=-1)


def apply_axial_rope(x, ang_r, ang_c):
    xf = x.astype(F32)
    out = jnp.concatenate([rope_axis(xf[..., :ROPE_AXIS_DIM], ang_r),
                           rope_axis(xf[..., ROPE_AXIS_DIM:], ang_c)], axis=-1)
    return out.astype(x.dtype)


def split_cols(p):
    B, L, _ = p.shape
    q, k, v, zu, zv, zf, gl = jnp.split(p, SPLIT_POINTS, axis=-1)
    return (q.reshape(B, L, DA_HEADS, 2, DA_HEAD_DIM),
            k.reshape(B, L, DA_HEADS, 2, DA_HEAD_DIM),
            v.reshape(B, L, DA_HEADS, DA_V_DIM),
            zu, zv, zf,
            gl.reshape(B, L, N_BRANCH, D_MODEL))


def diff_attend(q, k, v, lam):
    s = jnp.einsum('bqhmd,bkhmd->bhmqk', q, k).astype(F32) * (DA_HEAD_DIM ** -0.5)
    a = jax.nn.softmax(s, axis=-1)
    w = (a[:, :, 0] - lam * a[:, :, 1]).astype(v.dtype)
    return jnp.einsum('bhqk,bkhe->bqhe', w, v)


def latent_diff_attention(q, k_all, v_all, lam):
    B, L = q.shape[0], q.shape[1]
    nb = L // Q_BLOCK
    qb = jnp.moveaxis(q.reshape(B, nb, Q_BLOCK, DA_HEADS, 2, DA_HEAD_DIM), 1, 0)
    ob = lax.map(lambda qq: diff_attend(qq, k_all, v_all, lam), qb)
    return jnp.moveaxis(ob, 0, 1).reshape(B, L, DA_HEADS, DA_V_DIM)


def chunk_mlp(zu, zv, ln_g, w_s, b_s):
    B, L, _ = zu.shape
    u = jax.nn.gelu(zu, approximate=False)
    v = layernorm(jax.nn.gelu(zv, approximate=False), ln_g)
    vc = v.reshape(B, L // CM_CHUNK, CM_CHUNK, CM_GROUPS, CM_GROUP_W)
    s = jnp.einsum('gpq,bnqgc->bnpgc', w_s, vc) + b_s.T[:, :, None]
    return u * s.reshape(B, L, CM_WIDTH)


def fourier_mix(z):
    B, L, _ = z.shape
    zg = z.astype(F32).reshape(B, L, FN_GROUPS, FN_GROUP_W)
    return jnp.fft.fftn(zg, axes=(1, 3), norm='ortho').real.reshape(B, L, FN_WIDTH).astype(z.dtype)


def mixer_merge(att, zu, zv, zf, gl, lam_init, subln_g, cm_ln_g, cm_w_s, cm_b_s, w_branch, b_gate, w_out):
    B, L = att.shape[0], att.shape[1]
    a = (rmsnorm(att, subln_g) * (1.0 - lam_init)).reshape(B, L, DA_WIDTH)
    m = chunk_mlp(zu, zv, cm_ln_g, cm_w_s, cm_b_s)
    f = fourier_mix(zf)
    br = jnp.stack([a, m, f], axis=2)
    y = jnp.einsum('blnw,nwd->blnd', br, w_branch)
    g = jax.nn.sigmoid(gl + b_gate.reshape(N_BRANCH, D_MODEL))
    return jnp.sum(g * y, axis=2) @ w_out


def peer_ffn(h, w_q, sub_keys, u_tab, v_tab):
    B, L, D = h.shape
    hb = h.reshape(-1, PEER_TOKEN_BLOCK, D)

    def block(t):
        T = t.shape[0]
        q = rms_unit((t @ w_q).reshape(T, PEER_HEADS, 2, PEER_HALF))
        s = jnp.einsum('thpc,hpkc->thpk', q, sub_keys).astype(F32)
        s1, i1 = lax.top_k(s[:, :, 0], PEER_TOPK)
        s2, i2 = lax.top_k(s[:, :, 1], PEER_TOPK)
        cand_s = (s1[..., :, None] + s2[..., None, :]).reshape(T, PEER_HEADS, PEER_TOPK * PEER_TOPK)
        cand_i = (i1[..., :, None] * PEER_KEYS + i2[..., None, :]).reshape(T, PEER_HEADS, PEER_TOPK * PEER_TOPK)
        top_s, pos = lax.top_k(cand_s, PEER_TOPK)
        idx = jnp.take_along_axis(cand_i, pos, axis=-1)
        g = jax.nn.softmax(top_s, axis=-1)
        act = jax.nn.gelu(jnp.einsum('td,thkd->thk', t, u_tab[idx]).astype(F32), approximate=False)
        return jnp.einsum('thk,thkd->td', (g * act).astype(t.dtype), v_tab[idx])

    return lax.map(block, hb).reshape(B, L, D)


def setup_inputs(seed: int = 0) -> dict:
    key = jax.random.key(seed)
    ks = jax.random.split(key, 23)

    def nrm(k, shape, scale):
        return jax.random.normal(k, shape, F32) * scale

    D = D_MODEL
    return {
        'x': nrm(ks[0], (BATCH, SEQ, D), 1.0),
        'c': nrm(ks[1], (BATCH, D), 1.0),
        'ctx': nrm(ks[2], (BATCH, CTX_LEN, D), 1.0),
        'c_ctx': nrm(ks[3], (D,), 1.0),
        'w_ada': nrm(ks[4], (DEPTH, D, 6 * D), 0.5 * D ** -0.5),
        'b_ada': nrm(ks[5], (DEPTH, 6 * D), 0.02),
        'norm1_g': 1.0 + nrm(ks[6], (DEPTH, D), 0.02),
        'norm2_g': 1.0 + nrm(ks[7], (DEPTH, D), 0.02),
        'w_in': nrm(ks[8], (DEPTH, D, IN_COLS), D ** -0.5),
        'b_gate': nrm(ks[9], (DEPTH, N_BRANCH * D), 0.02),
        'q_norm_g': 1.0 + nrm(ks[10], (DEPTH, DA_HEAD_DIM), 0.02),
        'k_norm_g': 1.0 + nrm(ks[11], (DEPTH, DA_HEAD_DIM), 0.02),
        'lam_params': nrm(ks[12], (DEPTH, 4, DA_HEAD_DIM), 0.1),
        'subln_g': 1.0 + nrm(ks[13], (DEPTH, DA_V_DIM), 0.02),
        'cm_ln_g': 1.0 + nrm(ks[14], (DEPTH, CM_WIDTH), 0.02),
        'cm_w_s': nrm(ks[15], (DEPTH, CM_GROUPS, CM_CHUNK, CM_CHUNK), CM_CHUNK ** -0.5),
        'cm_b_s': 1.0 + nrm(ks[16], (DEPTH, CM_GROUPS, CM_CHUNK), 0.02),
        'w_branch': nrm(ks[17], (DEPTH, N_BRANCH, BRANCH_W, D), BRANCH_W ** -0.5),
        'w_out': nrm(ks[18], (DEPTH, D, D), D ** -0.5),
        'peer_w_q': nrm(ks[19], (DEPTH, D, PEER_HEADS * PEER_QDIM), D ** -0.5),
        'peer_sub_keys': nrm(ks[20], (DEPTH, PEER_HEADS, 2, PEER_KEYS, PEER_HALF), PEER_HALF ** -0.5),
        'peer_u': nrm(ks[21], (DEPTH, PEER_EXPERTS, D), D ** -0.5),
        'peer_v': nrm(ks[22], (DEPTH, PEER_EXPERTS, D), PEER_HEADS ** -0.5),
    }


def reference(x, c, ctx, c_ctx, w_ada, b_ada, norm1_g, norm2_g, w_in, b_gate, q_norm_g, k_norm_g,
              lam_params, subln_g, cm_ln_g, cm_w_s, cm_b_s, w_branch, w_out,
              peer_w_q, peer_sub_keys, peer_u, peer_v):
    B, L, D = x.shape
    Lc = ctx.shape[1]
    rows = L // GRID_W
    ang_r, ang_c = axial_angles(rows)
    c_act = jax.nn.silu(c)
    cc_act = jax.nn.silu(c_ctx)
    xc = ctx
    for l in range(DEPTH):
        last = l == DEPTH - 1
        lam_init = 0.8 - 0.6 * math.exp(-0.3 * l)
        lp = lam_params[l].astype(F32)
        lam = jnp.exp(jnp.sum(lp[0] * lp[1])) - jnp.exp(jnp.sum(lp[2] * lp[3])) + lam_init
        mod = (c_act @ w_ada[l] + b_ada[l]).reshape(B, 6, 1, D)
        mod_c = (cc_act @ w_ada[l] + b_ada[l]).reshape(6, 1, D)

        h = modulate(rmsnorm(x, norm1_g[l]), mod[:, 0], mod[:, 1])
        hc = modulate(rmsnorm(xc, norm1_g[l]), mod_c[0], mod_c[1])
        q, k, v, zu, zv, zf, gl = split_cols(h @ w_in[l])
        q = apply_axial_rope(rmsnorm(q, q_norm_g[l]), ang_r, ang_c)
        k = apply_axial_rope(rmsnorm(k, k_norm_g[l]), ang_r, ang_c)
        if last:
            kvc = hc @ w_in[l][:, SPLIT_POINTS[0]:SPLIT_POINTS[2]]
            kc = kvc[..., :DA_WIDTH].reshape(B, Lc, DA_HEADS, 2, DA_HEAD_DIM)
            vc = kvc[..., DA_WIDTH:].reshape(B, Lc, DA_HEADS, DA_V_DIM)
        else:
            qc, kc, vc, zuc, zvc, zfc, glc = split_cols(hc @ w_in[l])
        kc = rmsnorm(kc, k_norm_g[l])
        att = latent_diff_attention(q, jnp.concatenate([kc, k], axis=1),
                                    jnp.concatenate([vc, v], axis=1), lam)
        x = x + mod[:, 2] * mixer_merge(att, zu, zv, zf, gl, lam_init, subln_g[l], cm_ln_g[l], cm_w_s[l],
                                        cm_b_s[l], w_branch[l], b_gate[l], w_out[l])
        if not last:
            attc = diff_attend(rmsnorm(qc, q_norm_g[l]), kc, vc, lam)
            xc = xc + mod_c[2] * mixer_merge(attc, zuc, zvc, zfc, glc, lam_init, subln_g[l], cm_ln_g[l],
                                             cm_w_s[l], cm_b_s[l], w_branch[l], b_gate[l], w_out[l])

        h2 = modulate(rmsnorm(x, norm2_g[l]), mod[:, 3], mod[:, 4])
        x = x + mod[:, 5] * peer_ffn(h2, peer_w_q[l], peer_sub_keys[l], peer_u[l], peer_v[l])
        if not last:
            h2c = modulate(rmsnorm(xc, norm2_g[l]), mod_c[3], mod_c[4])
            xc = xc + mod_c[5] * peer_ffn(h2c, peer_w_q[l], peer_sub_keys[l], peer_u[l], peer_v[l])
    return x
```

```cpp
#include <hip/hip_runtime.h>
#include <hip/hip_cooperative_groups.h>
#include <cstdio>
namespace cg = cooperative_groups;

#ifndef USE_COOP
#define USE_COOP 1
#endif
#ifndef SELFCHECK
#define SELFCHECK 0
#endif

#define DI __device__ __forceinline__
typedef unsigned short bf16;
using bf16x8 = __attribute__((ext_vector_type(8))) short;
using f32x4  = __attribute__((ext_vector_type(4))) float;
using f32x16 = __attribute__((ext_vector_type(16))) float;

constexpr int D = 1024, NB = 8, SEQ = 4096, LC = 256, DEPTH = 4;
constexpr int NLAT = NB * SEQ, NCTX = NB * LC, MROWS = NLAT + NCTX;
constexpr int INC = 6144, LK = LC + SEQ;
constexpr int MT = MROWS / 128;
constexpr float EPS = 1e-6f;
constexpr float QSCALE = 0.125f * 1.4426950408889634f;

constexpr size_t SZ_X = (size_t)MROWS * D * 4, SZ_HB = (size_t)MROWS * D * 2, SZ_P = (size_t)MROWS * INC * 2;
constexpr size_t SZ_VT = (size_t)NB * 4 * 128 * LK * 2, SZ_BR = (size_t)MROWS * 1536 * 2, SZ_YZ = (size_t)MROWS * D * 2;
constexpr size_t OFF_X = 0;
constexpr size_t OFF_HB = OFF_X + SZ_X;
constexpr size_t OFF_P = OFF_HB + SZ_HB;
constexpr size_t OFF_VT = OFF_P + SZ_P;
constexpr size_t OFF_BR = OFF_VT + SZ_VT;
constexpr size_t OFF_YZ = OFF_BR + SZ_BR;
constexpr size_t OFF_WIN = OFF_YZ + SZ_YZ;
constexpr size_t OFF_WBR = OFF_WIN + (size_t)INC * D * 2;
constexpr size_t OFF_WOUT = OFF_WBR + (size_t)3 * D * 512 * 2;
constexpr size_t OFF_WQ = OFF_WOUT + (size_t)D * D * 2;
constexpr size_t OFF_U = OFF_WQ + (size_t)2048 * D * 2;
constexpr size_t OFF_V = OFF_U + (size_t)16384 * D * 2;
constexpr size_t OFF_KEYS = OFF_V + (size_t)16384 * D * 2;
constexpr size_t OFF_WS = OFF_KEYS + (size_t)DEPTH * 8 * 2 * 128 * 128 * 2;
constexpr size_t OFF_M1 = OFF_WS + (size_t)DEPTH * 4 * 128 * 128 * 2;
constexpr size_t OFF_M2 = OFF_M1 + (size_t)128 * 128 * 2;
constexpr size_t OFF_BAR = OFF_M2 + (size_t)4160 * 128 * 2;
constexpr size_t OFF_DC = OFF_BAR + 16384;
constexpr size_t OFF_FC = OFF_DC + (size_t)256 * 512 * 2;
constexpr size_t OFF_MOD = OFF_FC + (size_t)256 * 128 * 2;
constexpr size_t OFF_MODP = OFF_MOD + (size_t)DEPTH * 9 * INC * 4;
constexpr size_t OFF_ROPE = OFF_MODP + (size_t)DEPTH * 8 * 9 * INC * 4;
constexpr size_t OFF_USC = OFF_ROPE + 64 * 16 * 2 * 4;
constexpr size_t OFF_VSC = OFF_USC + 16384 * 4;
constexpr size_t WS_END = OFF_VSC + 16384 * 4;
constexpr size_t OFF_QP = OFF_P;
constexpr size_t OFF_SELI = OFF_BR;
constexpr size_t OFF_SELG = OFF_BR + (size_t)MROWS * 128 * 4;
constexpr size_t OFF_YS = OFF_YZ;
constexpr size_t OFF_A1S = OFF_HB;
constexpr size_t OFF_YTC = OFF_YZ + (size_t)NB * 4 * 2 * 128 * SEQ * 2;
constexpr size_t OFF_ZB = OFF_YZ;

constexpr int LDS_BYTES = 73728;

struct Params {
  const float *x, *c, *ctx, *c_ctx, *w_ada, *b_ada, *norm1_g, *norm2_g, *w_in, *b_gate, *q_norm_g, *k_norm_g,
      *lam_params, *subln_g, *cm_ln_g, *cm_w_s, *cm_b_s, *w_branch, *w_out, *peer_w_q, *peer_sub_keys, *peer_u, *peer_v;
  float* out;
  char* ws;
};

DI int opaque_tid() { int t = threadIdx.x; asm volatile("" : "+v"(t)); return t; }
DI int opaque_bid() { int b = blockIdx.x; asm volatile("" : "+s"(b)); return b; }
typedef __bf16 bf16x2_t __attribute__((ext_vector_type(2)));
typedef float f32x2_t __attribute__((ext_vector_type(2)));
DI unsigned pk2(float lo, float hi) { f32x2_t v = {lo, hi}; bf16x2_t b = __builtin_convertvector(v, bf16x2_t); return __builtin_bit_cast(unsigned, b); }
DI unsigned f2bf(float f) { return pk2(f, 0.f) & 0xffffu; }
DI float bf2f(unsigned b) { return __uint_as_float(b << 16); }
DI float bflo(unsigned w) { return __uint_as_float(w << 16); }
DI float bfhi(unsigned w) { return __uint_as_float(w & 0xffff0000u); }
DI float shx(float v, int m, int lane) { return __int_as_float(__builtin_amdgcn_ds_bpermute((lane ^ m) << 2, __float_as_int(v))); }
DI float shl(float v, int src, int lane) { (void)lane; return __int_as_float(__builtin_amdgcn_ds_bpermute(src << 2, __float_as_int(v))); }
DI float wave_sum_l(float v, int lane) {
#pragma unroll
  for (int o = 32; o >= 1; o >>= 1) v += shx(v, o, lane);
  return v;
}
#define wave_sum(v) wave_sum_l((v), lane)
DI float gelu_f(float x) { return 0.5f * x * (1.0f + erff(x * 0.70710678118654752f)); }
DI float cos_rev(float r) { return __builtin_amdgcn_cosf(r); }
DI float sin_rev(float r) { return __builtin_amdgcn_sinf(r); }
DI void unpack8(uint4 u, float* f) {
  f[0] = bflo(u.x); f[1] = bfhi(u.x); f[2] = bflo(u.y); f[3] = bfhi(u.y);
  f[4] = bflo(u.z); f[5] = bfhi(u.z); f[6] = bflo(u.w); f[7] = bfhi(u.w);
}
DI uint4 pack8(const float* f) {
  uint4 u; u.x = pk2(f[0], f[1]); u.y = pk2(f[2], f[3]); u.z = pk2(f[4], f[5]); u.w = pk2(f[6], f[7]); return u;
}
#define MFMA16(a, b, c) __builtin_amdgcn_mfma_f32_16x16x32_bf16((a), (b), (c), 0, 0, 0)
#define MFMA32(a, b, c) __builtin_amdgcn_mfma_f32_32x32x16_bf16((a), (b), (c), 0, 0, 0)

using u32x4 = __attribute__((ext_vector_type(4))) unsigned;
template <int BM, int BN, bool BKN>
DI void gemm_tile(const bf16* __restrict__ A, long lda, const bf16* __restrict__ B, long ldb, int K,
                  f32x4 (&acc)[4][4], char* smem, long a_half = -1, long b_half = -1) {
  if (a_half < 0) a_half = 64 * lda;
  if (b_half < 0) b_half = 64 * ldb;
  static_assert(BM == 128 && BN == 128, "128x128 only");
  constexpr int S = 72;
  bf16* As = (bf16*)smem;
  bf16* Bs = As + 128 * S;
  const int tid = opaque_tid(), lane = tid & 63, wave = tid >> 6, wm = wave >> 1, wn = wave & 1;
  const int nk = K >> 6;
  const int lrow = tid >> 3, lkc = tid & 7;
  const bf16* ag = A + (long)lrow * lda + lkc * 8;
  const bf16* bg = BKN ? (B + (long)(tid >> 4) * ldb + (tid & 15) * 8) : (B + (long)lrow * ldb + lkc * 8);
  const long astep = 32 * lda, bstep = BKN ? 16 * ldb : 32 * ldb;
  u32x4 xa0, xa1, xa2, xa3, xb0, xb1, xb2, xb3, ya0, ya1, ya2, ya3, yb0, yb1, yb2, yb3;
#define GT_LOAD(P_, k0)                                                  \
  {                                                                      \
    const bf16* ap_ = ag + (k0);                                         \
    P_##a0 = *(const u32x4*)(ap_); P_##a1 = *(const u32x4*)(ap_ + astep);        \
    P_##a2 = *(const u32x4*)(ap_ + a_half); P_##a3 = *(const u32x4*)(ap_ + a_half + astep); \
    const bf16* bp_ = BKN ? (bg + (long)(k0) * ldb) : (bg + (k0));       \
    P_##b0 = *(const u32x4*)(bp_); P_##b1 = *(const u32x4*)(bp_ + bstep);        \
    P_##b2 = *(const u32x4*)(bp_ + (BKN ? 2 * bstep : b_half)); P_##b3 = *(const u32x4*)(bp_ + (BKN ? 3 * bstep : b_half + bstep)); \
  }
#define GT_ST_KN(BsX, bv, i)                                             \
  {                                                                      \
    bf16* d_ = (BsX) + ((tid & 15) * 8) * S + (tid >> 4) + 16 * (i);     \
    d_[0 * S] = (bf16)(bv[0] & 0xffff); d_[1 * S] = (bf16)(bv[0] >> 16); \
    d_[2 * S] = (bf16)(bv[1] & 0xffff); d_[3 * S] = (bf16)(bv[1] >> 16); \
    d_[4 * S] = (bf16)(bv[2] & 0xffff); d_[5 * S] = (bf16)(bv[2] >> 16); \
    d_[6 * S] = (bf16)(bv[3] & 0xffff); d_[7 * S] = (bf16)(bv[3] >> 16); \
  }
  constexpr int BUFE = 2 * 128 * S;
#define GT_STORE(P_, buf)                                                                                 \
  {                                                                                                       \
    bf16* d = As + (buf) * BUFE + lrow * S + lkc * 8;                                                     \
    *(u32x4*)(d) = P_##a0; *(u32x4*)(d + 32 * S) = P_##a1; *(u32x4*)(d + 64 * S) = P_##a2; *(u32x4*)(d + 96 * S) = P_##a3; \
    if (!BKN) {                                                                                           \
      bf16* e = Bs + (buf) * BUFE + lrow * S + lkc * 8;                                                   \
      *(u32x4*)(e) = P_##b0; *(u32x4*)(e + 32 * S) = P_##b1; *(u32x4*)(e + 64 * S) = P_##b2; *(u32x4*)(e + 96 * S) = P_##b3; \
    } else {                                                                                              \
      bf16* BsB = Bs + (buf) * BUFE;                                                                      \
      GT_ST_KN(BsB, P_##b0, 0) GT_ST_KN(BsB, P_##b1, 1) GT_ST_KN(BsB, P_##b2, 2) GT_ST_KN(BsB, P_##b3, 3) \
    }                                                                                                     \
  }
#define GT_COMPUTE(buf)                                                                                   \
  {                                                                                                       \
    const bf16* ar = As + (buf) * BUFE + (wm * 64 + (lane & 15)) * S + (lane >> 4) * 8;                   \
    const bf16* br = Bs + (buf) * BUFE + (wn * 64 + (lane & 15)) * S + (lane >> 4) * 8;                   \
    _Pragma("unroll") for (int kk = 0; kk < 2; ++kk) {                                                    \
      const bf16x8 af0 = *(const bf16x8*)(ar + kk * 32), af1 = *(const bf16x8*)(ar + 16 * S + kk * 32);   \
      const bf16x8 af2 = *(const bf16x8*)(ar + 32 * S + kk * 32), af3 = *(const bf16x8*)(ar + 48 * S + kk * 32); \
      const bf16x8 bf0 = *(const bf16x8*)(br + kk * 32), bf1 = *(const bf16x8*)(br + 16 * S + kk * 32);   \
      const bf16x8 bf2 = *(const bf16x8*)(br + 32 * S + kk * 32), bf3 = *(const bf16x8*)(br + 48 * S + kk * 32); \
      acc[0][0] = MFMA16(af0, bf0, acc[0][0]); acc[0][1] = MFMA16(af0, bf1, acc[0][1]);                   \
      acc[0][2] = MFMA16(af0, bf2, acc[0][2]); acc[0][3] = MFMA16(af0, bf3, acc[0][3]);                   \
      acc[1][0] = MFMA16(af1, bf0, acc[1][0]); acc[1][1] = MFMA16(af1, bf1, acc[1][1]);                   \
      acc[1][2] = MFMA16(af1, bf2, acc[1][2]); acc[1][3] = MFMA16(af1, bf3, acc[1][3]);                   \
      acc[2][0] = MFMA16(af2, bf0, acc[2][0]); acc[2][1] = MFMA16(af2, bf1, acc[2][1]);                   \
      acc[2][2] = MFMA16(af2, bf2, acc[2][2]); acc[2][3] = MFMA16(af2, bf3, acc[2][3]);                   \
      acc[3][0] = MFMA16(af3, bf0, acc[3][0]); acc[3][1] = MFMA16(af3, bf1, acc[3][1]);                   \
      acc[3][2] = MFMA16(af3, bf2, acc[3][2]); acc[3][3] = MFMA16(af3, bf3, acc[3][3]);                   \
    }                                                                                                     \
  }
  GT_LOAD(x, 0)
  GT_LOAD(y, 64)
  __syncthreads();
  GT_STORE(x, 0)
  __syncthreads();
  for (int kt = 0; kt < nk; kt += 2) {
    if (kt + 2 < nk) GT_LOAD(x, (kt + 2) * 64)
    GT_COMPUTE(0)
    GT_STORE(y, 1)
    __syncthreads();
    if (kt + 3 < nk) GT_LOAD(y, (kt + 3) * 64)
    GT_COMPUTE(1)
    if (kt + 2 < nk) {
      GT_STORE(x, 0)
      __syncthreads();
    }
  }
#undef GT_STORE
#undef GT_COMPUTE
#undef GT_LOAD
#undef GT_ST_KN
}

DI void gemm_tile_d4(const bf16* __restrict__ A, long lda, const bf16* __restrict__ B, long ldb, int K,
                     f32x4 (&acc)[4][4], char* smem) {
  constexpr int S = 72;
  bf16* As = (bf16*)smem;
  bf16* Bs = As + 128 * S;
  const int tid = opaque_tid(), lane = tid & 63, wave = tid >> 6, wm = wave >> 1, wn = wave & 1;
  const int nk = K >> 6;
  const int lrow = tid >> 3, lkc = tid & 7;
  const bf16* ag = A + (long)lrow * lda + lkc * 8;
  const bf16* bg = B + (long)lrow * ldb + lkc * 8;
  const long astep = 32 * lda, bstep = 32 * ldb;
  u32x4 pa0, pa1, pa2, pa3, pb0, pb1, pb2, pb3, qa0, qa1, qa2, qa3, qb0, qb1, qb2, qb3, ra0, ra1, ra2, ra3, rb0, rb1, rb2, rb3;
#define G4_LOAD(P_, k0)                                                  \
  {                                                                      \
    const bf16* ap_ = ag + (k0);                                         \
    P_##a0 = *(const u32x4*)(ap_); P_##a1 = *(const u32x4*)(ap_ + astep);        \
    P_##a2 = *(const u32x4*)(ap_ + 2 * astep); P_##a3 = *(const u32x4*)(ap_ + 3 * astep); \
    const bf16* bp_ = bg + (k0);                                         \
    P_##b0 = *(const u32x4*)(bp_); P_##b1 = *(const u32x4*)(bp_ + bstep);        \
    P_##b2 = *(const u32x4*)(bp_ + 2 * bstep); P_##b3 = *(const u32x4*)(bp_ + 3 * bstep); \
  }
  constexpr int BUFE = 2 * 128 * S;
#define G4_STORE(P_, buf)                                                                                 \
  {                                                                                                       \
    bf16* d = As + (buf) * BUFE + lrow * S + lkc * 8;                                                     \
    *(u32x4*)(d) = P_##a0; *(u32x4*)(d + 32 * S) = P_##a1; *(u32x4*)(d + 64 * S) = P_##a2; *(u32x4*)(d + 96 * S) = P_##a3; \
    bf16* e = Bs + (buf) * BUFE + lrow * S + lkc * 8;                                                     \
    *(u32x4*)(e) = P_##b0; *(u32x4*)(e + 32 * S) = P_##b1; *(u32x4*)(e + 64 * S) = P_##b2; *(u32x4*)(e + 96 * S) = P_##b3; \
  }
#define G4_COMPUTE(buf)                                                                                   \
  {                                                                                                       \
    const bf16* ar = As + (buf) * BUFE + (wm * 64 + (lane & 15)) * S + (lane >> 4) * 8;                   \
    const bf16* br = Bs + (buf) * BUFE + (wn * 64 + (lane & 15)) * S + (lane >> 4) * 8;                   \
    _Pragma("unroll") for (int kk = 0; kk < 2; ++kk) {                                                    \
      const bf16x8 af0 = *(const bf16x8*)(ar + kk * 32), af1 = *(const bf16x8*)(ar + 16 * S + kk * 32);   \
      const bf16x8 af2 = *(const bf16x8*)(ar + 32 * S + kk * 32), af3 = *(const bf16x8*)(ar + 48 * S + kk * 32); \
      const bf16x8 bf0 = *(const bf16x8*)(br + kk * 32), bf1 = *(const bf16x8*)(br + 16 * S + kk * 32);   \
      const bf16x8 bf2 = *(const bf16x8*)(br + 32 * S + kk * 32), bf3 = *(const bf16x8*)(br + 48 * S + kk * 32); \
      acc[0][0] = MFMA16(af0, bf0, acc[0][0]); acc[0][1] = MFMA16(af0, bf1, acc[0][1]);                   \
      acc[0][2] = MFMA16(af0, bf2, acc[0][2]); acc[0][3] = MFMA16(af0, bf3, acc[0][3]);                   \
      acc[1][0] = MFMA16(af1, bf0, acc[1][0]); acc[1][1] = MFMA16(af1, bf1, acc[1][1]);                   \
      acc[1][2] = MFMA16(af1, bf2, acc[1][2]); acc[1][3] = MFMA16(af1, bf3, acc[1][3]);                   \
      acc[2][0] = MFMA16(af2, bf0, acc[2][0]); acc[2][1] = MFMA16(af2, bf1, acc[2][1]);                   \
      acc[2][2] = MFMA16(af2, bf2, acc[2][2]); acc[2][3] = MFMA16(af2, bf3, acc[2][3]);                   \
      acc[3][0] = MFMA16(af3, bf0, acc[3][0]); acc[3][1] = MFMA16(af3, bf1, acc[3][1]);                   \
      acc[3][2] = MFMA16(af3, bf2, acc[3][2]); acc[3][3] = MFMA16(af3, bf3, acc[3][3]);                   \
    }                                                                                                     \
  }
  G4_LOAD(p, 0)
  G4_LOAD(q, 64)
  G4_LOAD(r, 128)
  __syncthreads();
  G4_STORE(p, 0)
  if (3 < nk) G4_LOAD(p, 3 * 64)
  __syncthreads();
#define G4_STEP(j, buf, P_)                                          \
  if (kt + (j) < nk) {                                               \
    G4_COMPUTE(buf)                                                  \
    if (kt + (j) + 1 < nk) {                                         \
      G4_STORE(P_, (buf) ^ 1)                                        \
      if (kt + (j) + 4 < nk) G4_LOAD(P_, (kt + (j) + 4) * 64)        \
      __syncthreads();                                               \
    }                                                                \
  }
  for (int kt = 0; kt < nk; kt += 6) {
    G4_STEP(0, 0, q)
    G4_STEP(1, 1, r)
    G4_STEP(2, 0, p)
    G4_STEP(3, 1, q)
    G4_STEP(4, 0, r)
    G4_STEP(5, 1, p)
  }
#undef G4_STEP
#undef G4_LOAD
#undef G4_STORE
#undef G4_COMPUTE
}

#define ACC_ZERO(acc)                                                          \
  _Pragma("unroll") for (int mi_ = 0; mi_ < 4; ++mi_) _Pragma("unroll") for (int ni_ = 0; ni_ < 4; ++ni_) { \
    acc[mi_][ni_][0] = 0.f; acc[mi_][ni_][1] = 0.f; acc[mi_][ni_][2] = 0.f; acc[mi_][ni_][3] = 0.f; }

#define EPI_LOOP(acc, BODY)                                                                         \
  {                                                                                                 \
    const int tid_ = opaque_tid(); const int lane_ = tid_ & 63, wave_ = tid_ >> 6, wm_ = wave_ >> 1, wn_ = wave_ & 1; \
    _Pragma("unroll") for (int mi = 0; mi < 4; ++mi) _Pragma("unroll") for (int ni = 0; ni < 4; ++ni) \
        _Pragma("unroll") for (int r = 0; r < 4; ++r) {                                             \
      const int row = wm_ * 64 + mi * 16 + (lane_ >> 4) * 4 + r;                                    \
      const int col = wn_ * 64 + ni * 16 + (lane_ & 15);                                            \
      float v = acc[mi][ni][r];                                                                     \
      BODY                                                                                          \
    }                                                                                               \
  }

#define STAGE_ACC(acc, T)                          \
  {                                                \
    __syncthreads();                               \
    EPI_LOOP(acc, T[row * 132 + col] = v;)         \
    __syncthreads();                               \
  }
#define ROW_LOOP(T, ...)                                                                  \
  {                                                                                        \
    const int tid_r = opaque_tid();                                                        \
    const int col0 = (tid_r & 15) * 8;                                                     \
    _Pragma("unroll") for (int i_ = 0; i_ < 8; ++i_) {                                     \
      const int row = (tid_r >> 4) + 16 * i_;                                              \
      float v[8];                                                                          \
      {                                                                                    \
        const float4 a_ = *(const float4*)(T + row * 132 + col0);                          \
        const float4 b_ = *(const float4*)(T + row * 132 + col0 + 4);                      \
        v[0] = a_.x; v[1] = a_.y; v[2] = a_.z; v[3] = a_.w; v[4] = b_.x; v[5] = b_.y; v[6] = b_.z; v[7] = b_.w; \
      }                                                                                    \
      __VA_ARGS__                                                                          \
    }                                                                                      \
  }

DI void conv_t_tile(const float* __restrict__ W, int K, int N, bf16* __restrict__ WT, int tile, char* smem) {
  float* T = (float*)smem;
  const int tid = opaque_tid();
  const int ntn = N >> 6;
  const int k0 = (tile / ntn) * 64, n0 = (tile % ntn) * 64;
#pragma unroll
  for (int i = 0; i < 16; ++i) {
    int e = tid + i * 256; int kk = e >> 6, nn = e & 63;
    T[kk * 65 + nn] = W[(long)(k0 + kk) * N + n0 + nn];
  }
  __syncthreads();
#pragma unroll
  for (int i = 0; i < 16; ++i) {
    int e = tid + i * 256; int nn = e >> 6, kk = e & 63;
    WT[(long)(n0 + nn) * K + k0 + kk] = (bf16)f2bf(T[kk * 65 + nn]);
  }
  __syncthreads();
}
constexpr int CONV_ITEMS = 1536 + 384 + 256 + 512;
DI void conv_layer_item(const Params& p, int l, int it, char* smem) {
  char* ws = p.ws;
  if (it < 1536) conv_t_tile(p.w_in + (size_t)l * D * INC, D, INC, (bf16*)(ws + OFF_WIN), it, smem);
  else if (it < 1920) { int j = it - 1536; int n = j / 128;
    conv_t_tile(p.w_branch + ((size_t)l * 3 + n) * 512 * D, 512, D, (bf16*)(ws + OFF_WBR) + (size_t)n * D * 512, j % 128, smem); }
  else if (it < 2176) conv_t_tile(p.w_out + (size_t)l * D * D, D, D, (bf16*)(ws + OFF_WOUT), it - 1920, smem);
  else conv_t_tile(p.peer_w_q + (size_t)l * D * 2048, D, 2048, (bf16*)(ws + OFF_WQ), it - 2176, smem);
}
DI void conv_e_item(const float* __restrict__ src, bf16* __restrict__ dst, int it) {
  size_t o = (size_t)it * 2048 + opaque_tid() * 8;
  float4 a = *(const float4*)(src + o), b = *(const float4*)(src + o + 4);
  uint4 u; u.x = pk2(a.x, a.y); u.y = pk2(a.z, a.w); u.z = pk2(b.x, b.y); u.w = pk2(b.z, b.w);
  *(uint4*)(dst + o) = u;
}

DI void load_row_f32(const float* __restrict__ src, int lane, float* v) {
  float4 a = *(const float4*)(src + lane * 8), b = *(const float4*)(src + lane * 8 + 4);
  float4 c = *(const float4*)(src + 512 + lane * 8), d = *(const float4*)(src + 512 + lane * 8 + 4);
  v[0] = a.x; v[1] = a.y; v[2] = a.z; v[3] = a.w; v[4] = b.x; v[5] = b.y; v[6] = b.z; v[7] = b.w;
  v[8] = c.x; v[9] = c.y; v[10] = c.z; v[11] = c.w; v[12] = d.x; v[13] = d.y; v[14] = d.z; v[15] = d.w;
}
DI void store_row_f32(float* __restrict__ dst, int lane, const float* v) {
  *(float4*)(dst + lane * 8) = make_float4(v[0], v[1], v[2], v[3]);
  *(float4*)(dst + lane * 8 + 4) = make_float4(v[4], v[5], v[6], v[7]);
  *(float4*)(dst + 512 + lane * 8) = make_float4(v[8], v[9], v[10], v[11]);
  *(float4*)(dst + 512 + lane * 8 + 4) = make_float4(v[12], v[13], v[14], v[15]);
}
DI void normmod_store(const float* v, const float* __restrict__ g, const float* __restrict__ shift,
                      const float* __restrict__ scale, bf16* __restrict__ dst, int lane) {
  float ss = 0.f;
#pragma unroll
  for (int e = 0; e < 16; ++e) ss += v[e] * v[e];
  ss = wave_sum(ss);
  const float rn = rsqrtf(ss * (1.0f / 1024.0f) + EPS);
  float gg[16], sh[16], sc[16], o[16];
  load_row_f32(g, lane, gg); load_row_f32(shift, lane, sh); load_row_f32(scale, lane, sc);
#pragma unroll
  for (int e = 0; e < 16; ++e) o[e] = v[e] * rn * gg[e] * (1.0f + sc[e]) + sh[e];
  *(uint4*)(dst + lane * 8) = pack8(o);
  *(uint4*)(dst + 512 + lane * 8) = pack8(o + 8);
}

DI void load_row16_f32(const float* __restrict__ src, int lane, float* v) {
#pragma unroll
  for (int i = 0; i < 4; ++i) {
    float4 a = *(const float4*)(src + lane * 16 + i * 4);
    v[4 * i] = a.x; v[4 * i + 1] = a.y; v[4 * i + 2] = a.z; v[4 * i + 3] = a.w;
  }
}
DI void store_row16_f32(float* __restrict__ dst, int lane, const float* v) {
#pragma unroll
  for (int i = 0; i < 4; ++i) *(float4*)(dst + lane * 16 + i * 4) = make_float4(v[4 * i], v[4 * i + 1], v[4 * i + 2], v[4 * i + 3]);
}
DI void normmod_store16(const float* v, const float* __restrict__ g, const float* __restrict__ shift,
                        const float* __restrict__ scale, bf16* __restrict__ dst, int lane) {
  float ss = 0.f;
#pragma unroll
  for (int e = 0; e < 16; ++e) ss += v[e] * v[e];
  ss = wave_sum(ss);
  const float rn = rsqrtf(ss * (1.0f / 1024.0f) + EPS);
  float gg[16], sh[16], sc[16], o[16];
  load_row16_f32(g, lane, gg); load_row16_f32(shift, lane, sh); load_row16_f32(scale, lane, sc);
#pragma unroll
  for (int e = 0; e < 16; ++e) o[e] = v[e] * rn * gg[e] * (1.0f + sc[e]) + sh[e];
  *(uint4*)(dst + lane * 16) = pack8(o);
  *(uint4*)(dst + lane * 16 + 8) = pack8(o + 8);
}
DI void conv_fp8_row(const float* __restrict__ src, unsigned char* __restrict__ dst, float* __restrict__ sc, int lane) {
  float v[16];
  load_row16_f32(src, lane, v);
  float m = 0.f;
#pragma unroll
  for (int e = 0; e < 16; ++e) m = fmaxf(m, fabsf(v[e]));
#pragma unroll
  for (int o = 32; o >= 1; o >>= 1) m = fmaxf(m, shx(m, o, lane));
  const float s = m > 0.f ? 384.0f / m : 1.0f;
  u32x4 q;
#pragma unroll
  for (int w = 0; w < 4; ++w) {
    int x = 0;
    x = __builtin_amdgcn_cvt_pk_fp8_f32(v[4 * w] * s, v[4 * w + 1] * s, x, false);
    x = __builtin_amdgcn_cvt_pk_fp8_f32(v[4 * w + 2] * s, v[4 * w + 3] * s, x, true);
    q[w] = (unsigned)x;
  }
  *(u32x4*)(dst + lane * 16) = q;
  if (lane == 0) *sc = m > 0.f ? m * (1.0f / 384.0f) : 1.0f;
}
DI void conv_fp8_row2(const float* __restrict__ src, unsigned char* __restrict__ dst, float* __restrict__ sc, int lane) {
  float v[2][16];
  load_row16_f32(src, lane, v[0]);
  load_row16_f32(src + D, lane, v[1]);
#pragma unroll
  for (int rr = 0; rr < 2; ++rr) {
    float m = 0.f;
#pragma unroll
    for (int e = 0; e < 16; ++e) m = fmaxf(m, fabsf(v[rr][e]));
#pragma unroll
    for (int o = 32; o >= 1; o >>= 1) m = fmaxf(m, shx(m, o, lane));
    const float s = m > 0.f ? 384.0f / m : 1.0f;
    u32x4 q;
#pragma unroll
    for (int w = 0; w < 4; ++w) {
      int x = 0;
      x = __builtin_amdgcn_cvt_pk_fp8_f32(v[rr][4 * w] * s, v[rr][4 * w + 1] * s, x, false);
      x = __builtin_amdgcn_cvt_pk_fp8_f32(v[rr][4 * w + 2] * s, v[rr][4 * w + 3] * s, x, true);
      q[w] = (unsigned)x;
    }
    *(u32x4*)(dst + (size_t)rr * D + lane * 16) = q;
    if (lane == 0) sc[rr] = m > 0.f ? m * (1.0f / 384.0f) : 1.0f;
  }
}
DI float dot16_fp8(u32x4 q, const float* hv) {
  float s = 0.f;
#pragma unroll
  for (int w = 0; w < 4; ++w) {
    const f32x2_t lo = __builtin_amdgcn_cvt_pk_f32_fp8((int)q[w], false), hi = __builtin_amdgcn_cvt_pk_f32_fp8((int)q[w], true);
    s += lo[0] * hv[4 * w] + lo[1] * hv[4 * w + 1] + hi[0] * hv[4 * w + 2] + hi[1] * hv[4 * w + 3];
  }
  return s;
}
DI void axpy16_fp8(u32x4 q, float w_, float* o) {
#pragma unroll
  for (int w = 0; w < 4; ++w) {
    const f32x2_t lo = __builtin_amdgcn_cvt_pk_f32_fp8((int)q[w], false), hi = __builtin_amdgcn_cvt_pk_f32_fp8((int)q[w], true);
    o[4 * w] += w_ * lo[0]; o[4 * w + 1] += w_ * lo[1]; o[4 * w + 2] += w_ * hi[0]; o[4 * w + 3] += w_ * hi[1];
  }
}

DI int key_row(int b, int kb, int j) { return kb < 4 ? NLAT + b * LC + kb * 64 + j : b * SEQ + (kb - 4) * 64 + j; }

DI void attn_map(const bf16* __restrict__ Ksm, const bf16* __restrict__ Vsk, bf16x8 q0, bf16x8 q1, bf16x8 q2, bf16x8 q3, int pc, int c, int hh,
                 f32x16& O0, f32x16& O1, f32x16& O2, f32x16& O3, float negc, float& lrun) {
  f32x16 X0;
#pragma unroll
  for (int i = 0; i < 16; ++i) X0[i] = negc;
  {
    const bf16* kr = Ksm + pc * 136 + hh * 8;
    X0 = MFMA32(*(const bf16x8*)(kr), q0, X0);
    X0 = MFMA32(*(const bf16x8*)(kr + 16), q1, X0);
    X0 = MFMA32(*(const bf16x8*)(kr + 32), q2, X0);
    X0 = MFMA32(*(const bf16x8*)(kr + 48), q3, X0);
  }
  float ls = 0.f;
  if (__any(negc < 0.f)) {
#pragma unroll
    for (int i = 0; i < 16; ++i) { X0[i] = __builtin_amdgcn_exp2f(X0[i]); ls += X0[i]; }
  }
  lrun += ls;
  u32x4 u00, u01;
  u00[0] = pk2(X0[0], X0[1]); u00[1] = pk2(X0[2], X0[3]); u00[2] = pk2(X0[4], X0[5]); u00[3] = pk2(X0[6], X0[7]);
  u01[0] = pk2(X0[8], X0[9]); u01[1] = pk2(X0[10], X0[11]); u01[2] = pk2(X0[12], X0[13]); u01[3] = pk2(X0[14], X0[15]);
  const bf16x8 p00 = __builtin_bit_cast(bf16x8, u00), p01 = __builtin_bit_cast(bf16x8, u01);
  const bf16* vr = Vsk + c * 72 + hh * 8;
#define PV_STEP(pf, off)                                                                    \
  {                                                                                         \
    const bf16x8 v0 = *(const bf16x8*)(vr + (off)), v1 = *(const bf16x8*)(vr + 32 * 72 + (off)); \
    O0 = MFMA32(v0, pf, O0); O1 = MFMA32(v1, pf, O1);                                        \
    const bf16x8 v2 = *(const bf16x8*)(vr + 64 * 72 + (off)), v3 = *(const bf16x8*)(vr + 96 * 72 + (off)); \
    O2 = MFMA32(v2, pf, O2); O3 = MFMA32(v3, pf, O3);                                        \
  }
  PV_STEP(p00, 0) PV_STEP(p01, 16)
#undef PV_STEP
  __builtin_amdgcn_sched_barrier(0);
}

DI void attn_map2(const bf16* __restrict__ Ksm, const bf16* __restrict__ Vsk,
                  bf16x8 qa0, bf16x8 qa1, bf16x8 qa2, bf16x8 qa3, bf16x8 qb0, bf16x8 qb1, bf16x8 qb2, bf16x8 qb3, int pc, int c, int hh,
                  f32x16& A0, f32x16& A1, f32x16& A2, f32x16& A3, f32x16& B0, f32x16& B1, f32x16& B2, f32x16& B3,
                  float negc, float& lra, float& lrb) {
  f32x16 XA, XB;
#pragma unroll
  for (int i = 0; i < 16; ++i) { XA[i] = negc; XB[i] = negc; }
  {
    const bf16* kr = Ksm + pc * 136 + hh * 8;
    XA = MFMA32(*(const bf16x8*)(kr), qa0, XA);
    XA = MFMA32(*(const bf16x8*)(kr + 16), qa1, XA);
    XA = MFMA32(*(const bf16x8*)(kr + 32), qa2, XA);
    XA = MFMA32(*(const bf16x8*)(kr + 48), qa3, XA);
    XB = MFMA32(*(const bf16x8*)(kr + 64), qb0, XB);
    XB = MFMA32(*(const bf16x8*)(kr + 80), qb1, XB);
    XB = MFMA32(*(const bf16x8*)(kr + 96), qb2, XB);
    XB = MFMA32(*(const bf16x8*)(kr + 112), qb3, XB);
  }
  float lsa = 0.f, lsb = 0.f;
  if (__any(negc < 0.f)) {
#pragma unroll
    for (int i = 0; i < 16; ++i) { XA[i] = __builtin_amdgcn_exp2f(XA[i]); lsa += XA[i]; XB[i] = __builtin_amdgcn_exp2f(XB[i]); lsb += XB[i]; }
  }
  lra += lsa; lrb += lsb;
  u32x4 ua0, ua1, ub0, ub1;
  ua0[0] = pk2(XA[0], XA[1]); ua0[1] = pk2(XA[2], XA[3]); ua0[2] = pk2(XA[4], XA[5]); ua0[3] = pk2(XA[6], XA[7]);
  ua1[0] = pk2(XA[8], XA[9]); ua1[1] = pk2(XA[10], XA[11]); ua1[2] = pk2(XA[12], XA[13]); ua1[3] = pk2(XA[14], XA[15]);
  ub0[0] = pk2(XB[0], XB[1]); ub0[1] = pk2(XB[2], XB[3]); ub0[2] = pk2(XB[4], XB[5]); ub0[3] = pk2(XB[6], XB[7]);
  ub1[0] = pk2(XB[8], XB[9]); ub1[1] = pk2(XB[10], XB[11]); ub1[2] = pk2(XB[12], XB[13]); ub1[3] = pk2(XB[14], XB[15]);
  const bf16x8 pa0 = __builtin_bit_cast(bf16x8, ua0), pa1 = __builtin_bit_cast(bf16x8, ua1);
  const bf16x8 pb0 = __builtin_bit_cast(bf16x8, ub0), pb1 = __builtin_bit_cast(bf16x8, ub1);
  const bf16* vr = Vsk + c * 72 + hh * 8;
#define PV2_STEP(pfa, pfb, off)                                                              \
  {                                                                                          \
    const bf16x8 v0 = *(const bf16x8*)(vr + (off)), v1 = *(const bf16x8*)(vr + 32 * 72 + (off)); \
    A0 = MFMA32(v0, pfa, A0); B0 = MFMA32(v0, pfb, B0); A1 = MFMA32(v1, pfa, A1); B1 = MFMA32(v1, pfb, B1); \
    const bf16x8 v2 = *(const bf16x8*)(vr + 64 * 72 + (off)), v3 = *(const bf16x8*)(vr + 96 * 72 + (off)); \
    A2 = MFMA32(v2, pfa, A2); B2 = MFMA32(v2, pfb, B2); A3 = MFMA32(v3, pfa, A3); B3 = MFMA32(v3, pfb, B3); \
  }
  PV2_STEP(pa0, pb0, 0) PV2_STEP(pa1, pb1, 16)
#undef PV2_STEP
  __builtin_amdgcn_sched_barrier(0);
}

DI void attn_item(const Params& p, int layer_in, int b, int h, int q_row0, int nkb, char* smem) {
  const bf16* P = (const bf16*)(p.ws + OFF_P);
  const bf16* VT = (const bf16*)(p.ws + OFF_VT);
  bf16* BR = (bf16*)(p.ws + OFF_BR);
  bf16* Ks = (bf16*)smem;
  bf16* Vs = Ks + 64 * 136;
  bf16* Qs = Vs + 128 * 72;
  int layer = layer_in;
  int tid = opaque_tid();
  __syncthreads();
  const int lane = tid & 63, wave = tid >> 6;
  const int c = lane & 31, hh = lane >> 5;
  const int pc = (c & ~12) | ((c & 4) << 1) | ((c & 8) >> 1);
  const bf16* qgp = P + (long)(q_row0 + wave * 32 + c) * INC + h * 128 + hh * 8;
  const bf16x8 qa0 = *(const bf16x8*)(qgp), qa1 = *(const bf16x8*)(qgp + 16), qa2 = *(const bf16x8*)(qgp + 32), qa3 = *(const bf16x8*)(qgp + 48);
  const bf16x8 qb0 = *(const bf16x8*)(qgp + 64), qb1 = *(const bf16x8*)(qgp + 80), qb2 = *(const bf16x8*)(qgp + 96), qb3 = *(const bf16x8*)(qgp + 112);
  f32x16 O00, O01, O02, O03, O10, O11, O12, O13;
#pragma unroll
  for (int i = 0; i < 16; ++i) { O00[i] = 0.f; O01[i] = 0.f; O02[i] = 0.f; O03[i] = 0.f; O10[i] = 0.f; O11[i] = 0.f; O12[i] = 0.f; O13[i] = 0.f; }
  float l0r = 0.f, l1r = 0.f;
  float negc;
  {
    const float* gq = p.q_norm_g + layer * 64; const float* gk = p.k_norm_g + layer * 64;
    float mq = 0.f, mk = 0.f;
    for (int i = 0; i < 64; ++i) { mq = fmaxf(mq, fabsf(gq[i])); mk = fmaxf(mk, fabsf(gk[i])); }
    negc = -(8.0f * 1.4426950408889634f * 1.02f) * mq * mk;
  }

  const int kpart = tid & 15, kkey = tid >> 4;
  const int vpart = tid & 7, vdv = tid >> 3;
  for (int kb = 0; kb < nkb; ++kb) {
    const bf16* kg = P + (long)key_row(b, kb, kkey) * INC + 512 + h * 128 + kpart * 8;
    const bf16* vg = VT + ((long)(b * 4 + h) * 128 + vdv) * LK + kb * 64 + vpart * 8;
    const u32x4 k0 = *(const u32x4*)(kg), k1 = *(const u32x4*)(kg + 16 * INC), k2 = *(const u32x4*)(kg + 32 * INC), k3 = *(const u32x4*)(kg + 48 * INC);
    __syncthreads();
    {
      bf16* d = Ks + kkey * 136 + kpart * 8;
      *(u32x4*)(d) = k0; *(u32x4*)(d + 16 * 136) = k1; *(u32x4*)(d + 32 * 136) = k2; *(u32x4*)(d + 48 * 136) = k3;
    }
    {
      const u32x4 v0 = *(const u32x4*)(vg), v1 = *(const u32x4*)(vg + 32 * LK), v2 = *(const u32x4*)(vg + 64 * LK), v3 = *(const u32x4*)(vg + 96 * LK);
      bf16* e = Vs + vdv * 72 + vpart * 8;
      *(u32x4*)(e) = v0; *(u32x4*)(e + 32 * 72) = v1; *(u32x4*)(e + 64 * 72) = v2; *(u32x4*)(e + 96 * 72) = v3;
    }
    __syncthreads();
    attn_map2(Ks, Vs, qa0, qa1, qa2, qa3, qb0, qb1, qb2, qb3, pc, c, hh, O00, O01, O02, O03, O10, O11, O12, O13, negc, l0r, l1r);
    attn_map2(Ks + 32 * 136, Vs + 32, qa0, qa1, qa2, qa3, qb0, qb1, qb2, qb3, pc, c, hh, O00, O01, O02, O03, O10, O11, O12, O13, negc, l0r, l1r);
  }
  asm volatile("" : "+s"(layer));
  const float* lp = p.lam_params + layer * 256;
  float d01 = 0.f, d23 = 0.f;
  for (int i = 0; i < 64; ++i) { d01 += lp[i] * lp[64 + i]; d23 += lp[128 + i] * lp[192 + i]; }
  const float lam_init = 0.8f - 0.6f * expf(-0.3f * (float)layer);
  const float lam = expf(d01) - expf(d23) + lam_init;
  const float l0 = l0r + shx(l0r, 32, lane), l1 = l1r + shx(l1r, 32, lane);
  const float i0 = 1.0f / l0, i1 = lam / l1;
  float ss = 0.f;
#pragma unroll
  for (int i = 0; i < 16; ++i) {
    O00[i] = O00[i] * i0 - O10[i] * i1; O01[i] = O01[i] * i0 - O11[i] * i1;
    O02[i] = O02[i] * i0 - O12[i] * i1; O03[i] = O03[i] * i0 - O13[i] * i1;
    ss += O00[i] * O00[i] + O01[i] * O01[i] + O02[i] * O02[i] + O03[i] * O03[i];
  }
  ss += shx(ss, 32, lane);
  const float rn = rsqrtf(ss * (1.0f / 128.0f) + EPS) * (1.0f - lam_init);
  const float* sg = p.subln_g + layer * 128;
  __syncthreads();
  int tid2 = opaque_tid();
  const int c2 = tid2 & 31, hh2 = (tid2 >> 5) & 1, wave2 = tid2 >> 6;
  bf16* Os = (bf16*)smem;
  bf16* orow = Os + (wave2 * 32 + c2) * 136;
#pragma unroll
  for (int i = 0; i < 16; ++i) {
    const int dv = (i & 3) + 8 * (i >> 2) + 4 * hh2;
    orow[dv] = (bf16)f2bf(O00[i] * rn * sg[dv]);
    orow[32 + dv] = (bf16)f2bf(O01[i] * rn * sg[32 + dv]);
    orow[64 + dv] = (bf16)f2bf(O02[i] * rn * sg[64 + dv]);
    orow[96 + dv] = (bf16)f2bf(O03[i] * rn * sg[96 + dv]);
  }
  __syncthreads();
  {
    const int row = tid2 >> 4, part = tid2 & 15;
    bf16* og = BR + (long)(q_row0 + row) * 1536 + h * 128 + part * 8;
    const bf16* os = Os + row * 136 + part * 8;
#pragma unroll
    for (int i = 0; i < 8; ++i) *(u32x4*)(og + (long)i * 16 * 1536) = *(const u32x4*)(os + i * 16 * 136);
  }
  __syncthreads();
}

DI float med3f(float a, float b, float c) { return __builtin_amdgcn_fmed3f(a, b, c); }
#define TK_INS(V, xv)                                                            \
  {                                                                              \
    const float x_ = (xv);                                                       \
    _Pragma("unroll") for (int j_ = 15; j_ >= 1; --j_) V[j_] = med3f(V[j_ - 1], x_, V[j_]); \
    V[0] = fmaxf(V[0], x_);                                                      \
  }
#define TK_INSERT(V, I, xv, xi)                                          \
  {                                                                      \
    float x_ = (xv); int i_ = (xi);                                      \
    _Pragma("unroll") for (int j_ = 0; j_ < 16; ++j_) {                  \
      const bool gt_ = x_ > V[j_];                                       \
      const float tv_ = gt_ ? x_ : V[j_]; const int ti_ = gt_ ? i_ : I[j_]; \
      x_ = gt_ ? V[j_] : x_; i_ = gt_ ? I[j_] : i_;                      \
      V[j_] = tv_; I[j_] = ti_;                                          \
    }                                                                    \
  }
DI unsigned f2key(float x, unsigned tag, unsigned mask) {
  const unsigned b = __float_as_uint(x);
  const unsigned k = b ^ ((unsigned)((int)b >> 31) | 0x80000000u);
  return (k & ~mask) | tag;
}
DI float key2f(unsigned k, unsigned mask) {
  k &= ~mask;
  const unsigned b = k ^ ((k & 0x80000000u) ? 0x80000000u : 0xffffffffu);
  return __uint_as_float(b);
}
DI unsigned umed3(unsigned a, unsigned b, unsigned c) { return max(min(a, b), min(max(a, b), c)); }
#define TK_INSU(V, xv)                                                           \
  {                                                                              \
    const unsigned x_ = (xv);                                                    \
    _Pragma("unroll") for (int j_ = 15; j_ >= 1; --j_) V[j_] = umed3(V[j_ - 1], x_, V[j_]); \
    V[0] = max(V[0], x_);                                                        \
  }
#define TK_INS2(V, I, xv, xi)                                                    \
  {                                                                              \
    const float x_ = (xv); const int i_ = (xi);                                  \
    bool g_[16];                                                                 \
    _Pragma("unroll") for (int j_ = 0; j_ < 16; ++j_) g_[j_] = x_ > V[j_];       \
    _Pragma("unroll") for (int j_ = 15; j_ >= 1; --j_) {                         \
      I[j_] = g_[j_] ? (g_[j_ - 1] ? I[j_ - 1] : i_) : I[j_];                    \
      V[j_] = g_[j_] ? (g_[j_ - 1] ? V[j_ - 1] : x_) : V[j_];                    \
    }                                                                            \
    I[0] = g_[0] ? i_ : I[0]; V[0] = g_[0] ? x_ : V[0];                          \
  }
DI float tag_bits(float x, unsigned tag, unsigned mask) { return __uint_as_float((__float_as_uint(x) & ~mask) | tag); }

DI void peer_list(const bf16* __restrict__ qa, const bf16* __restrict__ keys, char* smem, float (&so)[16], int (&io)[16]) {
  const int tid = opaque_tid();
  const int t = tid & 127, half = tid >> 7;
  float* S = (float*)smem;
  float* XH = (float*)smem;
  {
    f32x4 acc[4][4];
    ACC_ZERO(acc)
    gemm_tile<128, 128, false>(qa, 2048, keys, 128, 128, acc, smem);
    __syncthreads();
    EPI_LOOP(acc, S[row * 129 + col] = v;)
  }
  __syncthreads();
  unsigned V[16];
#pragma unroll
  for (int j = 0; j < 16; ++j) V[j] = 0u;
  {
    const float* sr = S + t * 129 + half * 64;
#pragma unroll 4
    for (int k = 0; k < 64; ++k) TK_INSU(V, f2key(sr[k], 127u - (unsigned)(half * 64 + k), 127u))
  }
  __syncthreads();
  unsigned* XHU = (unsigned*)smem;
  if (half == 1) {
#pragma unroll
    for (int j = 0; j < 16; ++j) XHU[t * 17 + j] = V[j];
  }
  __syncthreads();
  if (half == 0) {
#pragma unroll
    for (int j = 0; j < 16; ++j) TK_INSU(V, XHU[t * 17 + j])
    float ss = 0.f;
#pragma unroll
    for (int i = 0; i < 16; ++i) {
      float f[8];
      unpack8(*(const uint4*)(qa + (size_t)t * 2048 + i * 8), f);
#pragma unroll
      for (int e = 0; e < 8; ++e) ss += f[e] * f[e];
    }
    const float rn = rsqrtf(ss * (1.0f / 128.0f) + EPS);
#pragma unroll
    for (int j = 0; j < 16; ++j) { io[j] = 127 - (int)(V[j] & 127u); so[j] = key2f(V[j], 127u) * rn; }
  } else {
#pragma unroll
    for (int j = 0; j < 16; ++j) { io[j] = 0; so[j] = 0.f; }
  }
  __syncthreads();
}

#define LAS __attribute__((address_space(3)))
#define XB_TMO      128
#define XB_XCNT(j)  (256  + 64 * (j))
#define XB_XSUB(j)  (1280 + 64 * (j))
#define XB_XGEN(j)  (2304 + 64 * (j))
#define XB_TOP      3328
#define XB_TOPGEN   3392
#define XCD_BAR_WORDS 3456
#define XB_SPIN_CAP (1u << 21)
DI unsigned xb_ld(unsigned* p) { return __hip_atomic_load(p, __ATOMIC_RELAXED, __HIP_MEMORY_SCOPE_AGENT); }
DI unsigned xb_add(unsigned* p, unsigned v) { return __hip_atomic_fetch_add(p, v, __ATOMIC_RELAXED, __HIP_MEMORY_SCOPE_AGENT); }
DI unsigned xb_xcc_id() { return (unsigned)__builtin_amdgcn_s_getreg((3 << 11) | 20) & 0xFu; }
#define XB_SPIN(cond, bar) do { unsigned _sp = 0; while (cond) { __builtin_amdgcn_s_sleep(1); \
    if ((++_sp & 255u) == 0u) { if (xb_ld(&(bar)[XB_TMO])) break; if (_sp > XB_SPIN_CAP) { atomicAdd(&(bar)[XB_TMO], 1u); break; } } } } while (0)
struct XcdBarrier { unsigned* bar; unsigned x; volatile LAS unsigned* st; };
DI XcdBarrier xcd_barrier_post(unsigned* bar, volatile LAS unsigned* st) {
  XcdBarrier b; b.bar = bar; b.x = xb_xcc_id(); b.st = st;
  if (threadIdx.x == 0) (void)xb_add(&bar[XB_XCNT(b.x)], 1u);
  return b;
}
DI void xcd_barrier_complete(unsigned* bar, unsigned x, unsigned& nloc, unsigned& nx) {
  const unsigned G = gridDim.x * gridDim.y * gridDim.z;
  unsigned sum, cnt, mine, sp = 0u;
  for (;;) {
    sum = 0u; cnt = 0u; mine = 0u;
#pragma unroll
    for (unsigned j = 0; j < 16; ++j) { const unsigned c = xb_ld(&bar[XB_XCNT(j)]); sum += c; cnt += (c > 0u) ? 1u : 0u; mine = (j == x) ? c : mine; }
    if (sum == G) break;
    __builtin_amdgcn_s_sleep(1);
    if ((++sp & 255u) == 0u) { if (xb_ld(&bar[XB_TMO])) break; if (sp > XB_SPIN_CAP) { atomicAdd(&bar[XB_TMO], 1u); break; } }
  }
  nloc = mine > 0u ? mine : 1u; nx = cnt > 0u ? cnt : 1u;
}
DI void xcd_barrier(const XcdBarrier& b) {
  asm volatile("s_waitcnt vmcnt(0)" ::: "memory");
  __syncthreads();
  if (threadIdx.x == 0) {
    unsigned* bar = b.bar;
    __builtin_amdgcn_s_waitcnt(0);
    unsigned nloc = b.st[0], nx = b.st[1];
    if (nloc == 0u) { xcd_barrier_complete(bar, b.x, nloc, nx); b.st[0] = nloc; b.st[1] = nx; }
    const unsigned old = xb_add(&bar[XB_XSUB(b.x)], 1u);
    const unsigned gen = old / nloc;
    if (old + 1u == (gen + 1u) * nloc) {
      __builtin_amdgcn_fence(__ATOMIC_RELEASE, "agent");
      asm volatile("s_waitcnt vmcnt(0)" ::: "memory");
      const unsigned og = xb_add(&bar[XB_TOP], 1u);
      const unsigned tg = og / nx;
      if (og + 1u == (tg + 1u) * nx) xb_add(&bar[XB_TOPGEN], 1u);
      else XB_SPIN(xb_ld(&bar[XB_TOPGEN]) == tg, bar);
      __builtin_amdgcn_fence(__ATOMIC_ACQUIRE, "agent");
      xb_add(&bar[XB_XGEN(b.x)], 1u);
      asm volatile("s_waitcnt vmcnt(0)" ::: "memory");
    } else {
      XB_SPIN(xb_ld(&bar[XB_XGEN(b.x)]) == gen, bar);
      __builtin_amdgcn_fence(__ATOMIC_ACQUIRE, "agent");
      asm volatile("s_waitcnt vmcnt(0)" ::: "memory");
    }
  }
  __syncthreads();
}

#define DYN_BEGIN(N_)                                                                       \
  {                                                                                         \
    unsigned* wq_ = (unsigned*)(ws + OFF_BAR) + 3584 + KIND + 16 * layer;                   \
    volatile LAS unsigned* nx_ = (volatile LAS unsigned*)(smem + LDS_BYTES) + 2;            \
    int it = bid;                                                                           \
    while (it < (N_)) {                                                                     \
      unsigned nxt_ = 0u;                                                                   \
      if (tid == 0) nxt_ = (unsigned)G + __hip_atomic_fetch_add(wq_, 1u, __ATOMIC_RELAXED, __HIP_MEMORY_SCOPE_AGENT);
#define DYN_END()                                                                           \
      __syncthreads();                                                                      \
      if (tid == 0) *nx_ = nxt_;                                                            \
      __syncthreads();                                                                      \
      it = (int)*nx_;                                                                       \
    }                                                                                       \
  }

constexpr int N_PHASES = 3 + 10 * DEPTH;

template <int KIND>
DI void phase_body(const Params& p, int layer, char* smem) {
  char* ws = p.ws;
  const int tid = opaque_tid(), lane = tid & 63, wave = tid >> 6;
  const int G = gridDim.x, bid = opaque_bid();
  float* X = (float*)(ws + OFF_X);
  bf16* HB = (bf16*)(ws + OFF_HB);
  bf16* P = (bf16*)(ws + OFF_P);
  const float* MOD = (const float*)(ws + OFF_MOD);

  if constexpr (KIND == 0) {
    constexpr int N_MODP = DEPTH * 24 * 8;
    constexpr int N_KEYS = DEPTH * 8 * 2 * 128 * 128 / 2048;
    constexpr int N_WS = DEPTH * 4 * 128 * 128 / 2048;
    constexpr int N_DL = 67, N_DC = 256, N_FC = 16, N_ROPE = 1;
    constexpr int E0 = N_MODP, E1 = E0 + CONV_ITEMS, E2 = E1 + N_KEYS, E3 = E2 + N_WS, E4 = E3 + N_DL, E5 = E4 + N_DC,
                  E6 = E5 + N_FC, E7 = E6 + N_ROPE;
    for (int it = bid; it < E7; it += G) {
      if (it < E0) {
        const int l = it / 192, rem = it % 192, cb = rem >> 3, kc = rem & 7;
        float* cs = (float*)smem;
        for (int i = tid; i < 9 * 128; i += 256) {
          int r = i >> 7, k = i & 127;
          float cv = (r < 8) ? p.c[r * D + kc * 128 + k] : p.c_ctx[kc * 128 + k];
          cs[i] = cv / (1.0f + expf(-cv));
        }
        __syncthreads();
        const int col = cb * 256 + tid;
        float a[9];
#pragma unroll
        for (int r = 0; r < 9; ++r) a[r] = 0.f;
        const float* w = p.w_ada + ((size_t)l * D + kc * 128) * INC + col;
#pragma unroll 4
        for (int k = 0; k < 128; ++k) {
          const float wv = w[(size_t)k * INC];
#pragma unroll
          for (int r = 0; r < 9; ++r) a[r] += cs[r * 128 + k] * wv;
        }
        float* mp = (float*)(ws + OFF_MODP) + ((size_t)(l * 8 + kc) * 9) * INC + col;
#pragma unroll
        for (int r = 0; r < 9; ++r) mp[(size_t)r * INC] = a[r];
        __syncthreads();
      } else if (it < E1) {
        conv_layer_item(p, 0, it - E0, smem);
      } else if (it < E2) {
        conv_e_item(p.peer_sub_keys, (bf16*)(ws + OFF_KEYS), it - E1);
      } else if (it < E3) {
        conv_e_item(p.cm_w_s, (bf16*)(ws + OFF_WS), it - E2);
      } else if (it < E4) {
        const int j = it - E3;
        for (int e8 = tid; e8 < 64 * 16; e8 += 256) {
          const int rr = e8 >> 4, c0 = (e8 & 15) * 8;
          float f[8];
          bf16* dst;
          if (j < 2) {
            const int row = j * 64 + rr; const int rip = row >> 6, s1 = row & 63;
#pragma unroll
            for (int e = 0; e < 8; ++e) {
              const int col = c0 + e; const int ri = col >> 6, t1 = col & 63;
              const float rev = (float)((s1 * t1) & 63) * (1.0f / 64.0f);
              const float cv = cos_rev(rev), sv = sin_rev(rev);
              f[e] = (rip == ri) ? cv : (rip == 0 ? sv : -sv);
            }
            dst = (bf16*)(ws + OFF_M1) + (size_t)row * 128 + c0;
          } else {
            const int row = (j - 2) * 64 + rr; const int s1 = row >> 6, s2 = row & 63; const int sfull = s1 + 64 * s2;
#pragma unroll
            for (int e = 0; e < 8; ++e) {
              const int col = c0 + e; const int rip = col >> 6, t2 = col & 63;
              const float rev = (float)((t2 * sfull) & 4095) * (1.0f / 4096.0f);
              f[e] = rip ? sin_rev(rev) : cos_rev(rev);
            }
            dst = (bf16*)(ws + OFF_M2) + (size_t)row * 128 + c0;
          }
          *(uint4*)dst = pack8(f);
        }
      } else if (it < E5) {
        const int s = it - E4;
        bf16* dc = (bf16*)(ws + OFF_DC) + (size_t)s * 512;
        if (tid < 64) {
          float f[8];
#pragma unroll
          for (int e = 0; e < 8; ++e) {
            const int j = tid * 8 + e; const int ri = j >> 8, t = j & 255;
            const float rev = (float)((s * t) & 255) * (1.0f / 256.0f);
            f[e] = ri ? sin_rev(rev) : cos_rev(rev);
          }
          *(uint4*)(dc + tid * 8) = pack8(f);
        }
      } else if (it < E6) {
        const int base = (it - E5) * 2048 + tid * 8;
        float f[8];
#pragma unroll
        for (int e = 0; e < 8; ++e) {
          const int idx = base + e; const int n = idx >> 7, cc = idx & 127; const int ri = n >> 7, kk = n & 127;
          const float rev = (float)((cc * kk) & 127) * (1.0f / 128.0f);
          f[e] = ri ? -sin_rev(rev) : cos_rev(rev);
        }
        *(uint4*)((bf16*)(ws + OFF_FC) + base) = pack8(f);
      } else {
        float* rope = (float*)(ws + OFF_ROPE);
        for (int i = tid; i < 64 * 16; i += 256) {
          const int pos = i >> 4, fi = i & 15;
          const float freq = exp2f(-(float)fi * (1.0f / 16.0f) * 13.287712379549449f);
          const float ang = (float)pos * freq;
          float rev = ang * 0.15915494309189535f;
          rev -= floorf(rev);
          rope[i * 2] = cos_rev(rev);
          rope[i * 2 + 1] = sin_rev(rev);
        }
      }
    }
    return;
  }
  if constexpr (KIND == 1) {
    const float* mp = (const float*)(ws + OFF_MODP);
    float* mo = (float*)(ws + OFF_MOD);
    for (int i = bid * 256 + tid; i < DEPTH * 9 * INC; i += G * 256) {
      const int l = i / (9 * INC), rem = i % (9 * INC), col = rem % INC;
      float s = p.b_ada[l * INC + col];
#pragma unroll
      for (int kc = 0; kc < 8; ++kc) s += mp[(size_t)(l * 8 + kc) * 9 * INC + rem];
      mo[i] = s;
    }
    return;
  }
  if constexpr (KIND == 2) {
    for (int it = bid; it < MROWS / 4; it += G) {
      const int r = it * 4 + wave;
      const bool isc = r >= NLAT;
      const float* src = isc ? p.ctx + (size_t)(r - NLAT) * D : p.x + (size_t)r * D;
      const int brow = isc ? 8 : r / SEQ;
      float v[16];
      load_row_f32(src, lane, v);
      store_row_f32(X + (size_t)r * D, lane, v);
      const float* m = MOD + (size_t)(0 * 9 + brow) * INC;
      normmod_store(v, p.norm1_g, m, m + D, HB + (size_t)r * D, lane);
    }
    return;
  }
  const float* MODL = MOD + (size_t)layer * 9 * INC;

  if constexpr (KIND == 3) {
    const bf16* W = (const bf16*)(ws + OFF_WIN);
    for (int it = bid; it < MT * 48; it += G) {
      const int mt = it / 48, nt = it % 48;
      f32x4 acc[4][4];
      ACC_ZERO(acc)
      gemm_tile_d4(HB + (size_t)mt * 128 * D, D, W + (size_t)nt * 128 * D, D, D, acc, smem);
      bf16* out = P + (size_t)mt * 128 * INC + nt * 128;
      float* T = (float*)smem;
      STAGE_ACC(acc, T)
      ROW_LOOP(T, *(uint4*)(out + (size_t)row * INC + col0) = pack8(v);)
    }
    return;
  }
  if constexpr (KIND == 4) {
    const float* rope = (const float*)(ws + OFF_ROPE);
    const float* qg = p.q_norm_g + layer * 64;
    const float* kg = p.k_norm_g + layer * 64;
    const float* lng = p.cm_ln_g + layer * 512;
    constexpr int NA = MROWS / 4, NBt = NB * 68 * 4, NC = NB * 4 * 2 * 32 + 16 * 4 * 2;
    for (int it = bid; it < NA + NBt + NC; it += G) {
      if (it < NA) {
        const int r = it * 4 + wave;
        const bool isc = r >= NLAT;
        const int t = r & (SEQ - 1);
        bf16* pr = P + (size_t)r * INC;
        const int j = lane & 7;
        const int pos = (j < 4) ? (t >> 6) : (t & 63);
        const uint4 rq_ = *(const uint4*)(pr + lane * 8), rk_ = *(const uint4*)(pr + 512 + lane * 8);
        const uint4 ru_ = *(const uint4*)(pr + 1536 + lane * 8), rv_ = *(const uint4*)(pr + 2048 + lane * 8);
        float cs[8], sn[8];
#pragma unroll
        for (int e = 0; e < 8; ++e) {
          const int fi = (j & 1) * 8 + e;
          cs[e] = rope[(pos * 16 + fi) * 2]; sn[e] = rope[(pos * 16 + fi) * 2 + 1];
        }
#pragma unroll
        for (int qk = 0; qk < 2; ++qk) {
          const float* g = qk ? kg : qg;
          float v[8];
          unpack8(qk ? rk_ : rq_, v);
          float ss = 0.f;
#pragma unroll
          for (int e = 0; e < 8; ++e) ss += v[e] * v[e];
          ss += shx(ss, 1, lane); ss += shx(ss, 2, lane); ss += shx(ss, 4, lane);
          const float rn = rsqrtf(ss * (1.0f / 64.0f) + EPS);
#pragma unroll
          for (int e = 0; e < 8; ++e) v[e] = v[e] * rn * g[j * 8 + e];
          float o[8];
#pragma unroll
          for (int e = 0; e < 8; ++e) {
            const float pv = shx(v[e], 2, lane);
            const float rot = (j & 2) ? (v[e] * cs[e] + pv * sn[e]) : (v[e] * cs[e] - pv * sn[e]);
            o[e] = isc ? v[e] : rot;
            if (qk == 0) o[e] *= QSCALE;
          }
          *(uint4*)(pr + qk * 512 + lane * 8) = pack8(o);
        }
        {
          float v[8];
          unpack8(ru_, v);
#pragma unroll
          for (int e = 0; e < 8; ++e) v[e] = gelu_f(v[e]);
          *(uint4*)(pr + 1536 + lane * 8) = pack8(v);
        }
        {
          float v[8];
          unpack8(rv_, v);
          float s = 0.f;
#pragma unroll
          for (int e = 0; e < 8; ++e) { v[e] = gelu_f(v[e]); s += v[e]; }
          const float mean = wave_sum(s) * (1.0f / 512.0f);
          float q = 0.f;
#pragma unroll
          for (int e = 0; e < 8; ++e) { v[e] -= mean; q += v[e] * v[e]; }
          const float rn = rsqrtf(wave_sum(q) * (1.0f / 512.0f) + EPS);
#pragma unroll
          for (int e = 0; e < 8; ++e) v[e] = v[e] * rn * lng[lane * 8 + e];
          *(uint4*)(pr + 2048 + lane * 8) = pack8(v);
        }
      } else if (it < NA + NBt) {
        const int j = it - NA; const int h = j & 3, kb = (j >> 2) % 68, b = j / (4 * 68);
        bf16* T = (bf16*)smem;
#pragma unroll
        for (int i = 0; i < 4; ++i) {
          int cc = tid + i * 256; int key = cc >> 4, part = cc & 15;
          *(uint4*)(T + key * 136 + part * 8) = *(const uint4*)(P + (size_t)key_row(b, kb, key) * INC + 1024 + h * 128 + part * 8);
        }
        __syncthreads();
        bf16* VT = (bf16*)(ws + OFF_VT);
#pragma unroll
        for (int i = 0; i < 4; ++i) {
          int cc = tid + i * 256; int dv = cc >> 3, part = cc & 7;
          uint4 u;
          u.x = (unsigned)T[(part * 8 + 0) * 136 + dv] | ((unsigned)T[(part * 8 + 1) * 136 + dv] << 16);
          u.y = (unsigned)T[(part * 8 + 2) * 136 + dv] | ((unsigned)T[(part * 8 + 3) * 136 + dv] << 16);
          u.z = (unsigned)T[(part * 8 + 4) * 136 + dv] | ((unsigned)T[(part * 8 + 5) * 136 + dv] << 16);
          u.w = (unsigned)T[(part * 8 + 6) * 136 + dv] | ((unsigned)T[(part * 8 + 7) * 136 + dv] << 16);
          *(uint4*)(VT + ((size_t)(b * 4 + h) * 128 + dv) * LK + kb * 64 + part * 8) = u;
        }
        __syncthreads();
      } else {
        const int j = it - NA - NBt;
        f32x4 acc[4][4];
        ACC_ZERO(acc)
        if (j < NB * 4 * 2 * 32) {
          const int jj = j & 31, ri = (j >> 5) & 1, g = (j >> 6) & 3, b = j >> 8;
          gemm_tile<128, 128, false>(P + (size_t)(b * SEQ + 2 * jj) * INC + 2560 + g * 128, (long)64 * INC,
                                     (const bf16*)(ws + OFF_FC) + (size_t)ri * 128 * 128, 128, 128, acc, smem, INC);
          bf16* ys = (bf16*)(ws + OFF_YS);
          const int wm_ = wave >> 1, wn_ = wave & 1;
          const int t2 = 2 * jj + wm_;
#pragma unroll
          for (int mi = 0; mi < 4; ++mi)
#pragma unroll
            for (int ni = 0; ni < 4; ++ni) {
              const int t1 = mi * 16 + (lane >> 4) * 4;
              const int kk = wn_ * 64 + ni * 16 + (lane & 15);
              uint2 u; u.x = pk2(acc[mi][ni][0], acc[mi][ni][1]); u.y = pk2(acc[mi][ni][2], acc[mi][ni][3]);
              *(uint2*)(ys + ((((size_t)(b * 4 + g) * 64 + t2) * 128 + kk) * 2 + ri) * 64 + t1) = u;
            }
        } else {
          const int jc = j - NB * 4 * 2 * 32; const int ri = jc & 1, g = (jc >> 1) & 3, mtc = jc >> 3;
          const int r0 = NLAT + mtc * 128;
          gemm_tile<128, 128, false>(P + (size_t)r0 * INC + 2560 + g * 128, INC,
                                     (const bf16*)(ws + OFF_FC) + (size_t)ri * 128 * 128, 128, 128, acc, smem);
          const int b = (r0 - NLAT) / LC, t0 = (r0 - NLAT) % LC;
          bf16* yt = (bf16*)(ws + OFF_YTC) + ((size_t)((b * 4 + g) * 2 + ri) * 128) * LC + t0;
          const int wm_ = wave >> 1, wn_ = wave & 1;
#pragma unroll
          for (int mi = 0; mi < 4; ++mi)
#pragma unroll
            for (int ni = 0; ni < 4; ++ni) {
              const int row = wm_ * 64 + mi * 16 + (lane >> 4) * 4;
              const int col = wn_ * 64 + ni * 16 + (lane & 15);
              uint2 u; u.x = pk2(acc[mi][ni][0], acc[mi][ni][1]); u.y = pk2(acc[mi][ni][2], acc[mi][ni][3]);
              *(uint2*)(yt + (size_t)col * LC + row) = u;
            }
        }
      }
    }
    return;
  }
  if constexpr (KIND == 5) {
    bf16* BR = (bf16*)(ws + OFF_BR);
    constexpr int N_AL = NB * 4 * 32, N_DL = NB * 4 * 64, N_CG = MT * 4, N_AC = NB * 4 * 2, N_DC = NB * 4 * 2;
    for (int it = bid; it < N_AL + N_AC; it += G) {
      int b, h, q0, nkb;
      if (it < N_AL) { const int qb = it & 31; h = (it >> 5) & 3; b = it >> 7; q0 = b * SEQ + qb * 128; nkb = 68; }
      else { const int j = it - N_AL; const int qb = j & 1; h = (j >> 1) & 3; b = j >> 3; q0 = NLAT + b * LC + qb * 128; nkb = 4; }
      attn_item(p, layer, b, h, q0, nkb, smem);
    }
#ifndef DBG_ATTN_ONLY
    for (int it = bid; it < N_DL + N_DC; it += G) {
      f32x4 acc[4][4];
      ACC_ZERO(acc)
      if (it < N_DL) {
        const int jj = it & 63, g = (it >> 6) & 3, b = it >> 8;
        const bf16* ys = (const bf16*)(ws + OFF_YS) + ((size_t)(b * 4 + g) * 64 * 128 + 2 * jj) * 128;
        gemm_tile<128, 128, false>(ys, (long)128 * 128, (const bf16*)(ws + OFF_M1), 128, 128, acc, smem, 128);
        bf16* a1 = (bf16*)(ws + OFF_A1S);
        const int wm_ = wave >> 1, wn_ = wave & 1;
        const int kk = 2 * jj + wm_;
#pragma unroll
        for (int mi = 0; mi < 4; ++mi)
#pragma unroll
          for (int ni = 0; ni < 4; ++ni) {
            const int t2 = mi * 16 + (lane >> 4) * 4;
            const int n = wn_ * 64 + ni * 16 + (lane & 15); const int rip = n >> 6, s1 = n & 63;
            uint2 u; u.x = pk2(acc[mi][ni][0], acc[mi][ni][1]); u.y = pk2(acc[mi][ni][2], acc[mi][ni][3]);
            *(uint2*)(a1 + ((((size_t)(b * 4 + g) * 64 + s1) * 128 + kk) * 2 + rip) * 64 + t2) = u;
          }
      } else {
        const int j = it - N_DL; const int mt = j & 1, g = (j >> 1) & 3, b = j >> 3;
        const bf16* DM = (const bf16*)(ws + OFF_DC) + (size_t)mt * 128 * 512;
        const bf16* yt = (const bf16*)(ws + OFF_YTC) + (size_t)((b * 4 + g) * 2) * 128 * LC;
        gemm_tile<128, 128, false>(DM, 2 * LC, yt, LC, LC, acc, smem);
        gemm_tile<128, 128, false>(DM + LC, 2 * LC, yt + (size_t)128 * LC, LC, LC, acc, smem);
        bf16* out = BR + (size_t)(NLAT + b * LC + mt * 128) * 1536 + 1024 + g * 128;
        const float nrm = 0.005524271728019903f;
        float* T = (float*)smem;
        STAGE_ACC(acc, T)
        ROW_LOOP(T, {
          float o[8];
_Pragma("unroll")
          for (int e = 0; e < 8; ++e) o[e] = v[e] * nrm;
          *(uint4*)(out + (size_t)row * 1536 + col0) = pack8(o);
        })
      }
    }
    for (int it = bid; it < N_CG; it += G) {
      const int g = it & 3, ci = it >> 2;
      f32x4 acc[4][4];
      ACC_ZERO(acc)
      gemm_tile<128, 128, true>((const bf16*)(ws + OFF_WS) + (size_t)(layer * 4 + g) * 128 * 128, 128,
                                P + (size_t)ci * 128 * INC + 2048 + g * 128, INC, 128, acc, smem);
      const float* bs = p.cm_b_s + (layer * 4 + g) * 128;
      const bf16* up = P + (size_t)ci * 128 * INC + 1536 + g * 128;
      bf16* out = BR + (size_t)ci * 128 * 1536 + 512 + g * 128;
      float* T = (float*)smem;
      STAGE_ACC(acc, T)
      ROW_LOOP(T, {
        float uv[8], o[8];
        unpack8(*(const uint4*)(up + (size_t)row * INC + col0), uv);
        const float bsr = bs[row];
_Pragma("unroll")
        for (int e = 0; e < 8; ++e) o[e] = uv[e] * (v[e] + bsr);
        *(uint4*)(out + (size_t)row * 1536 + col0) = pack8(o);
      })
    }
#endif
    return;
  }
  if constexpr (KIND == 12) {
    bf16* BR = (bf16*)(ws + OFF_BR);
    for (int it = bid; it < NB * 4 * 64; it += G) {
      const int s1 = it & 63, g = (it >> 6) & 3, b = it >> 8;
      f32x4 acc[4][4];
      ACC_ZERO(acc)
      gemm_tile<128, 128, false>((const bf16*)(ws + OFF_M2) + (size_t)s1 * 64 * 128, 128,
                                 (const bf16*)(ws + OFF_A1S) + ((size_t)(b * 4 + g) * 64 + s1) * 128 * 128, 128, 128, acc, smem);
      bf16* out = BR + (size_t)(b * SEQ + s1) * 1536 + 1024 + g * 128;
      const float nrm = 0.001381067932004976f;
      float* T = (float*)smem;
      STAGE_ACC(acc, T)
      ROW_LOOP(T, {
        if (row < 64) {
          float o[8];
_Pragma("unroll")
          for (int e = 0; e < 8; ++e) o[e] = v[e] * nrm;
          *(uint4*)(out + (size_t)row * 64 * 1536 + col0) = pack8(o);
        }
      })
    }
    return;
  }
  if constexpr (KIND == 6) {
    const bf16* BR = (const bf16*)(ws + OFF_BR);
    const bf16* W = (const bf16*)(ws + OFF_WBR);
    bf16* ZB = (bf16*)(ws + OFF_ZB);
    DYN_BEGIN(MT * 8)
      const int mt = it >> 3, nt = it & 7;
      float z[8][8];
#pragma unroll
      for (int i = 0; i < 8; ++i)
#pragma unroll
        for (int e = 0; e < 8; ++e) z[i][e] = 0.f;
      float* T = (float*)smem;
#pragma unroll 1
      for (int n = 0; n < 3; ++n) {
        f32x4 acc[4][4];
        ACC_ZERO(acc)
        gemm_tile<128, 128, false>(BR + (size_t)mt * 128 * 1536 + n * 512, 1536, W + ((size_t)n * D + nt * 128) * 512, 512, 512, acc, smem);
        const bf16* gl = P + (size_t)mt * 128 * INC + 3072 + n * D + nt * 128;
        const float* bg = p.b_gate + (size_t)layer * 3 * D + n * D + nt * 128;
        STAGE_ACC(acc, T)
        ROW_LOOP(T, {
          float gv[8];
          unpack8(*(const uint4*)(gl + (size_t)row * INC + col0), gv);
          const float4 b0 = *(const float4*)(bg + col0), b1 = *(const float4*)(bg + col0 + 4);
          const float bb[8] = {b0.x, b0.y, b0.z, b0.w, b1.x, b1.y, b1.z, b1.w};
_Pragma("unroll")
          for (int e = 0; e < 8; ++e) z[i_][e] += v[e] / (1.0f + __expf(-(gv[e] + bb[e])));
        })
      }
      bf16* out = ZB + (size_t)mt * 128 * D + nt * 128;
      {
        const int tid_r = opaque_tid();
        const int col0 = (tid_r & 15) * 8;
#pragma unroll
        for (int i_ = 0; i_ < 8; ++i_) {
          const int row = (tid_r >> 4) + 16 * i_;
          *(uint4*)(out + (size_t)row * D + col0) = pack8(z[i_]);
        }
      }
    DYN_END()
    return;
  }
  if constexpr (KIND == 7) {
    const bf16* ZB = (const bf16*)(ws + OFF_ZB);
    const bf16* W = (const bf16*)(ws + OFF_WOUT);
    DYN_BEGIN(MT * 8)
      const int mt = it >> 3, nt = it & 7;
      f32x4 acc[4][4];
      ACC_ZERO(acc)
      gemm_tile_d4(ZB + (size_t)mt * 128 * D, D, W + (size_t)nt * 128 * D, D, D, acc, smem);
      const int r0 = mt * 128;
      const int brow = r0 >= NLAT ? 8 : r0 / SEQ;
      const float* gate = MODL + (size_t)brow * INC + 2 * D + nt * 128;
      float* xo = X + (size_t)r0 * D + nt * 128;
      float* T = (float*)smem;
      STAGE_ACC(acc, T)
      ROW_LOOP(T, {
        float* xp = xo + (size_t)row * D + col0;
        float4 x0 = *(const float4*)xp, x1 = *(const float4*)(xp + 4);
        const float4 g0 = *(const float4*)(gate + col0), g1 = *(const float4*)(gate + col0 + 4);
        x0.x += g0.x * v[0]; x0.y += g0.y * v[1]; x0.z += g0.z * v[2]; x0.w += g0.w * v[3];
        x1.x += g1.x * v[4]; x1.y += g1.y * v[5]; x1.z += g1.z * v[6]; x1.w += g1.w * v[7];
        *(float4*)xp = x0; *(float4*)(xp + 4) = x1;
      })
    DYN_END()
    return;
  }
  if constexpr (KIND == 8) {
    constexpr int NA = MROWS / 8, NU = 16384 / 8;
    for (int it = bid; it < NA + 2 * NU; it += G) {
      if (it < NA) {
        const int r = it * 8 + wave * 2;
        const int brow = r >= NLAT ? 8 : r / SEQ;
        float v0[16], v1[16];
        load_row_f32(X + (size_t)r * D, lane, v0);
        load_row_f32(X + (size_t)(r + 1) * D, lane, v1);
        const float* m = MODL + (size_t)brow * INC;
        normmod_store(v0, p.norm2_g + layer * D, m + 3 * D, m + 4 * D, HB + (size_t)r * D, lane);
        normmod_store(v1, p.norm2_g + layer * D, m + 3 * D, m + 4 * D, HB + (size_t)(r + 1) * D, lane);
      } else {
        const bool isu = it < NA + NU;
        const int row = (it - NA - (isu ? 0 : NU)) * 8 + wave * 2;
        const float* src = (isu ? p.peer_u : p.peer_v) + ((size_t)layer * 16384 + row) * D;
        unsigned char* dst = (unsigned char*)(ws + (isu ? OFF_U : OFF_V)) + (size_t)row * D;
        float* sc = (float*)(ws + (isu ? OFF_USC : OFF_VSC)) + row;
        conv_fp8_row2(src, dst, sc, lane);
      }
    }
    return;
  }
  if constexpr (KIND == 9) {
    const bf16* W = (const bf16*)(ws + OFF_WQ);
    bf16* QP = (bf16*)(ws + OFF_QP);
    DYN_BEGIN(MT * 16)
      const int mt = it >> 4, nt = it & 15;
      f32x4 acc[4][4];
      ACC_ZERO(acc)
      gemm_tile_d4(HB + (size_t)mt * 128 * D, D, W + (size_t)nt * 128 * D, D, D, acc, smem);
      bf16* out = QP + (size_t)mt * 128 * 2048 + nt * 128;
      float* T = (float*)smem;
      STAGE_ACC(acc, T)
      ROW_LOOP(T, *(uint4*)(out + (size_t)row * 2048 + col0) = pack8(v);)
    DYN_END()
    return;
  }
  if constexpr (KIND == 10) {
    const bf16* QP = (const bf16*)(ws + OFF_QP);
    int* SELI = (int*)(ws + OFF_SELI);
    float* SELG = (float*)(ws + OFF_SELG);
    const int nconv = (layer + 1 < DEPTH) ? CONV_ITEMS : 0;
    DYN_BEGIN(MT * 8 + nconv)
      if (it >= MT * 8) { conv_layer_item(p, layer + 1, it - MT * 8, smem); } else {
      const int mt = it >> 3, h = it & 7;
#if SELFCHECK
      for (int rep = 0; rep < 2; ++rep) {
#endif
      float s1[16], s2[16]; int i1[16], i2[16];
      peer_list(QP + (size_t)mt * 128 * 2048 + (h * 2 + 0) * 128, (const bf16*)(ws + OFF_KEYS) + (size_t)((layer * 8 + h) * 2 + 0) * 128 * 128, smem, s1, i1);
      peer_list(QP + (size_t)mt * 128 * 2048 + (h * 2 + 1) * 128, (const bf16*)(ws + OFF_KEYS) + (size_t)((layer * 8 + h) * 2 + 1) * 128 * 128, smem, s2, i2);
      if (tid < 128) {
        float tv[16]; int ti[16];
#pragma unroll
        for (int j = 0; j < 16; ++j) { tv[j] = -INFINITY; ti[j] = 0; }
#pragma unroll
        for (int a = 0; a < 16; ++a)
#pragma unroll
          for (int b2 = 0; b2 < 16; ++b2)
            if ((a + 1) * (b2 + 1) <= 16) TK_INS2(tv, ti, s1[a] + s2[b2], i1[a] * 128 + i2[b2])
        float e[16], sum = 0.f;
#pragma unroll
        for (int j = 0; j < 16; ++j) { e[j] = __expf(tv[j] - tv[0]); sum += e[j]; }
        const float inv = 1.0f / sum;
        const size_t o = ((size_t)(mt * 128 + tid) * 8 + h) * 16;
#if SELFCHECK
        if (rep == 1) {
          bool bad = false;
#pragma unroll
          for (int j = 0; j < 16; ++j) bad |= (SELI[o + j] != ti[j]) || (__float_as_uint(SELG[o + j]) != __float_as_uint(e[j] * inv));
          if (bad) atomicOr((unsigned*)(ws + OFF_BAR) + 8, 1u);
        }
#endif
#pragma unroll
        for (int j = 0; j < 16; j += 4) {
          *(int4*)(SELI + o + j) = make_int4(ti[j], ti[j + 1], ti[j + 2], ti[j + 3]);
          *(float4*)(SELG + o + j) = make_float4(e[j] * inv, e[j + 1] * inv, e[j + 2] * inv, e[j + 3] * inv);
        }
      }
      __syncthreads();
#if SELFCHECK
      }
#endif
      }
    DYN_END()
    return;
  }
  if constexpr (KIND == 11) {
    const unsigned char* U8 = (const unsigned char*)(ws + OFF_U);
    const unsigned char* V8 = (const unsigned char*)(ws + OFF_V);
    const float* USC = (const float*)(ws + OFF_USC);
    const float* VSC = (const float*)(ws + OFF_VSC);
    const int* SELI = (const int*)(ws + OFF_SELI);
    const float* SELG = (const float*)(ws + OFF_SELG);
    const bool last = layer == DEPTH - 1;
    const int nrows = last ? NLAT : MROWS;
    for (int it = bid; it < nrows / 4; it += G) {
      const int r = it * 4 + wave;
      const int brow = r >= NLAT ? 8 : r / SEQ;
      float hv[16], o[16];
      unpack8(*(const uint4*)(HB + (size_t)r * D + lane * 16), hv);
      unpack8(*(const uint4*)(HB + (size_t)r * D + lane * 16 + 8), hv + 8);
      float xv[16], g2[16];
      load_row16_f32(X + (size_t)r * D, lane, xv);
      load_row16_f32(MODL + (size_t)brow * INC + 5 * D, lane, g2);
#pragma unroll
      for (int e = 0; e < 16; ++e) o[e] = 0.f;
      const int idA = SELI[(size_t)r * 128 + lane], idB = SELI[(size_t)r * 128 + 64 + lane];
      const float gA = SELG[(size_t)r * 128 + lane], gB = SELG[(size_t)r * 128 + 64 + lane];
      const float usA = USC[idA], usB = USC[idB], vsA = VSC[idA], vsB = VSC[idB];
      const int sub4 = (lane >> 4) & 3;
      u32x4 uqa[4], vqa[4], uqb[4], vqb[4];
#define PG_LOAD(uq, vq, gi)                                                                   \
  {                                                                                           \
    const int idr_ = (gi) < 16 ? idA : idB;                                                   \
    _Pragma("unroll") for (int j = 0; j < 4; ++j) {                                           \
      const int e_ = __builtin_amdgcn_readlane(idr_, (((gi) & 15) << 2) + j);                 \
      uq[j] = *(const u32x4*)(U8 + (size_t)e_ * D + lane * 16);                               \
      vq[j] = *(const u32x4*)(V8 + (size_t)e_ * D + lane * 16);                               \
    }                                                                                         \
  }
#define PG_COMPUTE(uq, vq, gi)                                                                \
  {                                                                                           \
    const float d0 = dot16_fp8(uq[0], hv), d1 = dot16_fp8(uq[1], hv), d2 = dot16_fp8(uq[2], hv), d3 = dot16_fp8(uq[3], hv); \
                  \
    const bool b5 = lane & 32, b4 = lane & 16;                                                \
    float k0 = b5 ? d2 : d0, k1 = b5 ? d3 : d1;                                               \
    k0 += shx(b5 ? d0 : d2, 32, lane); k1 += shx(b5 ? d1 : d3, 32, lane);                  \
    float dd = b4 ? k1 : k0;                                                                  \
    dd += shx(b4 ? k0 : k1, 16, lane);                                                       \
    dd += shx(dd, 8, lane); dd += shx(dd, 4, lane); dd += shx(dd, 2, lane); dd += shx(dd, 1, lane); \
    const int src_ = (((gi) & 15) << 2) + sub4;                                               \
    const float us_ = shl((gi) < 16 ? usA : usB, src_, lane), vs_ = shl((gi) < 16 ? vsA : vsB, src_, lane); \
    const float gg_ = shl((gi) < 16 ? gA : gB, src_, lane);                                      \
    const float w_ = gg_ * gelu_f(dd * us_) * vs_;                                            \
    _Pragma("unroll") for (int j = 0; j < 4; ++j) {                                           \
      const float wj = __uint_as_float(__builtin_amdgcn_readlane(__float_as_uint(w_), j * 16)); \
      axpy16_fp8(vq[j], wj, o);                                                               \
    }                                                                                         \
  }
      PG_LOAD(uqa, vqa, 0)
#pragma unroll 1
      for (int gi = 0; gi < 32; gi += 2) {
        __builtin_amdgcn_sched_barrier(0);
        PG_LOAD(uqb, vqb, gi + 1)
        __builtin_amdgcn_sched_barrier(0);
        PG_COMPUTE(uqa, vqa, gi)
        __builtin_amdgcn_sched_barrier(0);
        if (gi + 2 < 32) PG_LOAD(uqa, vqa, gi + 2)
        __builtin_amdgcn_sched_barrier(0);
        PG_COMPUTE(uqb, vqb, gi + 1)
        __builtin_amdgcn_sched_barrier(0);
      }
#undef PG_LOAD
#undef PG_COMPUTE
#pragma unroll
      for (int e = 0; e < 16; ++e) xv[e] += g2[e] * o[e];
      if (last) {
#if SELFCHECK
        if (__hip_atomic_load((unsigned*)(ws + OFF_BAR) + 8, __ATOMIC_RELAXED, __HIP_MEMORY_SCOPE_AGENT) != 0u) xv[0] = __uint_as_float(0x7fc00000u);
#endif
        store_row16_f32(p.out + (size_t)r * D, lane, xv);
      } else {
        store_row16_f32(X + (size_t)r * D, lane, xv);
        const float* m = MOD + (size_t)((layer + 1) * 9 + brow) * INC;
        normmod_store16(xv, p.norm1_g + (layer + 1) * D, m, m + D, HB + (size_t)r * D, lane);
      }
    }
    return;
  }
}

DI void run_phase(const Params& p, int ph, char* smem) {
  if (ph == 0) { phase_body<0>(p, 0, smem); return; }
  if (ph == 1) { phase_body<1>(p, 0, smem); return; }
  if (ph == 2) { phase_body<2>(p, 0, smem); return; }
  const int layer = (ph - 3) / 10, sub = (ph - 3) % 10;
  switch (sub) {
    case 0: phase_body<3>(p, layer, smem); break;
    case 1: phase_body<4>(p, layer, smem); break;
    case 2: phase_body<5>(p, layer, smem); break;
    case 3: phase_body<12>(p, layer, smem); break;
    case 4: phase_body<6>(p, layer, smem); break;
    case 5: phase_body<7>(p, layer, smem); break;
    case 6: phase_body<8>(p, layer, smem); break;
    case 7: phase_body<9>(p, layer, smem); break;
    case 8: phase_body<10>(p, layer, smem); break;
    default: phase_body<11>(p, layer, smem); break;
  }
}

#ifndef SYNC_CG
#define SYNC_CG 0
#endif
#ifndef PROBE_KIND
#define PROBE_KIND -1
#endif
#if USE_COOP
__global__ void __launch_bounds__(256, 2) fwd_kernel(Params p, int ph_lo, int ph_hi) {
  extern __shared__ __attribute__((aligned(16))) char smem[];
  volatile LAS unsigned* st = (volatile LAS unsigned*)(smem + LDS_BYTES);
  if (threadIdx.x == 0) { st[0] = 0u; st[1] = 0u; st[2] = 0u; st[3] = 0u; }
  __syncthreads();
  const XcdBarrier bar = xcd_barrier_post((unsigned*)(p.ws + OFF_BAR), st);
  cg::this_grid().sync();
  for (int ph = ph_lo; ph < ph_hi; ++ph) {
    run_phase(p, ph, smem);
#if PROBE_KIND >= 0
    {
      const int sub_ = (ph - 3) % 10, layer_ = (ph - 3) / 10;
      const int kind_ = sub_ == 0 ? 3 : sub_ == 1 ? 4 : sub_ == 2 ? 5 : sub_ == 3 ? 12 : sub_ + 2;
      bool rep = ph >= 3 && kind_ == PROBE_KIND;
      if (PROBE_KIND == 11) rep = rep && layer_ == DEPTH - 1;
      if (rep) { xcd_barrier(bar); run_phase(p, ph, smem); }
    }
#endif
    if (ph + 1 < ph_hi) {
#if SYNC_CG
      cg::this_grid().sync();
#else
      xcd_barrier(bar);
#endif
    }
  }
}
#else
template <int KIND>
__global__ void __launch_bounds__(256, 2) phase_kernel(Params p, int layer) {
  extern __shared__ __attribute__((aligned(16))) char smem[];
  phase_body<KIND>(p, layer, smem);
}
template <int KIND>
static void launch_phase(const Params& p, int layer, int grid, hipStream_t stream) {
  static bool attr = false;
  if (!attr) { (void)hipFuncSetAttribute((const void*)phase_kernel<KIND>, hipFuncAttributeMaxDynamicSharedMemorySize, LDS_BYTES); attr = true; }
  hipLaunchKernelGGL(phase_kernel<KIND>, dim3(grid), dim3(256), LDS_BYTES, stream, p, layer);
}
#endif

extern "C" void kernel_launch(void* const* d_in, const int* in_sizes, int n_in, void* d_out, int out_size, void* d_ws,
                              size_t ws_size, hipStream_t stream) {
  static int grid = 0;
  if (grid == 0) {
    if (ws_size < WS_END) { fprintf(stderr, "kernel_launch: workspace too small: need %zu have %zu\n", (size_t)WS_END, ws_size); grid = -1; return; }
    int dev = 0, cus = 0, per_cu = 0;
    (void)hipGetDevice(&dev);
    (void)hipDeviceGetAttribute(&cus, hipDeviceAttributeMultiprocessorCount, dev);
#if USE_COOP
    (void)hipFuncSetAttribute((const void*)fwd_kernel, hipFuncAttributeMaxDynamicSharedMemorySize, LDS_BYTES + 16);
    (void)hipOccupancyMaxActiveBlocksPerMultiprocessor(&per_cu, (const void*)fwd_kernel, 256, LDS_BYTES + 16);
    if (per_cu < 1) per_cu = 1;
    if (per_cu > 2) per_cu = 2;
#else
    per_cu = 2;
#endif
    if (cus < 1) cus = 256;
    grid = cus * per_cu;
    (void)hipGetLastError();
  }
  if (grid < 0) return;
  Params p{};
  const float** pf = (const float**)&p;
  for (int i = 0; i < 23; ++i) pf[i] = (const float*)d_in[i];
  p.out = (float*)d_out;
  p.ws = (char*)d_ws;
#if USE_COOP
  int lo = 0, hi = N_PHASES;
  void* args[] = {&p, &lo, &hi};
  (void)hipMemsetAsync((char*)d_ws + OFF_BAR, 0, 16384, stream);
  hipError_t e = hipLaunchCooperativeKernel((const void*)fwd_kernel, dim3(grid), dim3(256), args, LDS_BYTES + 16, stream);
  if (e != hipSuccess) fprintf(stderr, "cooperative launch failed: %s (grid %d)\n", hipGetErrorString(e), grid);
#else
  launch_phase<0>(p, 0, grid, stream);
  launch_phase<1>(p, 0, grid, stream);
  launch_phase<2>(p, 0, grid, stream);
  for (int l = 0; l < DEPTH; ++l) {
    launch_phase<3>(p, l, grid, stream); launch_phase<4>(p, l, grid, stream); launch_phase<5>(p, l, grid, stream); launch_phase<12>(p, l, grid, stream);
    launch_phase<6>(p, l, grid, stream); launch_phase<7>(p, l, grid, stream); launch_phase<8>(p, l, grid, stream);
    launch_phase<9>(p, l, grid, stream); launch_phase<10>(p, l, grid, stream); launch_phase<11>(p, l, grid, stream);
  }
#endif
}
```

```cpp
#include <hip/hip_runtime.h>
#include <hip/hip_cooperative_groups.h>
#include <cstdio>
namespace cg = cooperative_groups;

#ifndef USE_COOP
#define USE_COOP 1
#endif
#ifndef SELFCHECK
#define SELFCHECK 0
#endif

#define DI __device__ __forceinline__
typedef unsigned short bf16;
using bf16x8 = __attribute__((ext_vector_type(8))) short;
using f32x4  = __attribute__((ext_vector_type(4))) float;
using f32x16 = __attribute__((ext_vector_type(16))) float;

constexpr int D = 1024, NB = 8, SEQ = 4096, LC = 256, DEPTH = 4;
constexpr int NLAT = NB * SEQ, NCTX = NB * LC, MROWS = NLAT + NCTX;
constexpr int INC = 6144, LK = LC + SEQ;
constexpr int MT = MROWS / 128;
constexpr float EPS = 1e-6f;
constexpr float QSCALE = 0.125f * 1.4426950408889634f;

constexpr size_t SZ_X = (size_t)MROWS * D * 4, SZ_HB = (size_t)MROWS * D * 2, SZ_P = (size_t)MROWS * INC * 2;
constexpr size_t SZ_VT = (size_t)NB * 4 * 128 * LK * 2, SZ_BR = (size_t)MROWS * 1536 * 2, SZ_YZ = (size_t)MROWS * D * 2;
constexpr size_t OFF_X = 0;
constexpr size_t OFF_HB = OFF_X + SZ_X;
constexpr size_t OFF_P = OFF_HB + SZ_HB;
constexpr size_t OFF_VT = OFF_P + SZ_P;
constexpr size_t OFF_BR = OFF_VT + SZ_VT;
constexpr size_t OFF_YZ = OFF_BR + SZ_BR;
constexpr size_t OFF_WIN = OFF_YZ + SZ_YZ;
constexpr size_t OFF_WBR = OFF_WIN + (size_t)INC * D * 2;
constexpr size_t OFF_WOUT = OFF_WBR + (size_t)3 * D * 512 * 2;
constexpr size_t OFF_WQ = OFF_WOUT + (size_t)D * D * 2;
constexpr size_t OFF_U = OFF_WQ + (size_t)2048 * D * 2;
constexpr size_t OFF_V = OFF_U + (size_t)16384 * D * 2;
constexpr size_t OFF_KEYS = OFF_V + (size_t)16384 * D * 2;
constexpr size_t OFF_WS = OFF_KEYS + (size_t)DEPTH * 8 * 2 * 128 * 128 * 2;
constexpr size_t OFF_M1 = OFF_WS + (size_t)DEPTH * 4 * 128 * 128 * 2;
constexpr size_t OFF_M2 = OFF_M1 + (size_t)128 * 128 * 2;
constexpr size_t OFF_BAR = OFF_M2 + (size_t)4160 * 128 * 2;
constexpr size_t OFF_DC = OFF_BAR + 16384;
constexpr size_t OFF_FC = OFF_DC + (size_t)256 * 512 * 2;
constexpr size_t OFF_MOD = OFF_FC + (size_t)256 * 128 * 2;
constexpr size_t OFF_MODP = OFF_MOD + (size_t)DEPTH * 9 * INC * 4;
constexpr size_t OFF_ROPE = OFF_MODP + (size_t)DEPTH * 8 * 9 * INC * 4;
constexpr size_t OFF_USC = OFF_ROPE + 64 * 16 * 2 * 4;
constexpr size_t OFF_VSC = OFF_USC + 16384 * 4;
constexpr size_t WS_END = OFF_VSC + 16384 * 4;
constexpr size_t OFF_QP = OFF_P;
constexpr size_t OFF_SELI = OFF_BR;
constexpr size_t OFF_SELG = OFF_BR + (size_t)MROWS * 128 * 4;
constexpr size_t OFF_YS = OFF_YZ;
constexpr size_t OFF_A1S = OFF_HB;
constexpr size_t OFF_YTC = OFF_YZ + (size_t)NB * 4 * 2 * 128 * SEQ * 2;
constexpr size_t OFF_ZB = OFF_YZ;

constexpr int LDS_BYTES = 73728;

struct Params {
  const float *x, *c, *ctx, *c_ctx, *w_ada, *b_ada, *norm1_g, *norm2_g, *w_in, *b_gate, *q_norm_g, *k_norm_g,
      *lam_params, *subln_g, *cm_ln_g, *cm_w_s, *cm_b_s, *w_branch, *w_out, *peer_w_q, *peer_sub_keys, *peer_u, *peer_v;
  float* out;
  char* ws;
};

DI int opaque_tid() { int t = threadIdx.x; asm volatile("" : "+v"(t)); return t; }
DI int opaque_bid() { int b = blockIdx.x; asm volatile("" : "+s"(b)); return b; }
typedef __bf16 bf16x2_t __attribute__((ext_vector_type(2)));
typedef float f32x2_t __attribute__((ext_vector_type(2)));
DI unsigned pk2(float lo, float hi) { f32x2_t v = {lo, hi}; bf16x2_t b = __builtin_convertvector(v, bf16x2_t); return __builtin_bit_cast(unsigned, b); }
DI unsigned f2bf(float f) { return pk2(f, 0.f) & 0xffffu; }
DI float bf2f(unsigned b) { return __uint_as_float(b << 16); }
DI float bflo(unsigned w) { return __uint_as_float(w << 16); }
DI float bfhi(unsigned w) { return __uint_as_float(w & 0xffff0000u); }
DI float shx(float v, int m, int lane) { return __int_as_float(__builtin_amdgcn_ds_bpermute((lane ^ m) << 2, __float_as_int(v))); }
DI float shl(float v, int src, int lane) { (void)lane; return __int_as_float(__builtin_amdgcn_ds_bpermute(src << 2, __float_as_int(v))); }
DI float wave_sum_l(float v, int lane) {
#pragma unroll
  for (int o = 32; o >= 1; o >>= 1) v += shx(v, o, lane);
  return v;
}
#define wave_sum(v) wave_sum_l((v), lane)
DI float gelu_f(float x) { return 0.5f * x * (1.0f + erff(x * 0.70710678118654752f)); }
DI float cos_rev(float r) { return __builtin_amdgcn_cosf(r); }
DI float sin_rev(float r) { return __builtin_amdgcn_sinf(r); }
DI void unpack8(uint4 u, float* f) {
  f[0] = bflo(u.x); f[1] = bfhi(u.x); f[2] = bflo(u.y); f[3] = bfhi(u.y);
  f[4] = bflo(u.z); f[5] = bfhi(u.z); f[6] = bflo(u.w); f[7] = bfhi(u.w);
}
DI uint4 pack8(const float* f) {
  uint4 u; u.x = pk2(f[0], f[1]); u.y = pk2(f[2], f[3]); u.z = pk2(f[4], f[5]); u.w = pk2(f[6], f[7]); return u;
}
#define MFMA16(a, b, c) __builtin_amdgcn_mfma_f32_16x16x32_bf16((a), (b), (c), 0, 0, 0)
#define MFMA32(a, b, c) __builtin_amdgcn_mfma_f32_32x32x16_bf16((a), (b), (c), 0, 0, 0)

using u32x4 = __attribute__((ext_vector_type(4))) unsigned;
template <int BM, int BN, bool BKN>
DI void gemm_tile(const bf16* __restrict__ A, long lda, const bf16* __restrict__ B, long ldb, int K,
                  f32x4 (&acc)[4][4], char* smem, long a_half = -1, long b_half = -1) {
  if (a_half < 0) a_half = 64 * lda;
  if (b_half < 0) b_half = 64 * ldb;
  static_assert(BM == 128 && BN == 128, "128x128 only");
  constexpr int S = 72;
  bf16* As = (bf16*)smem;
  bf16* Bs = As + 128 * S;
  const int tid = opaque_tid(), lane = tid & 63, wave = tid >> 6, wm = wave >> 1, wn = wave & 1;
  const int nk = K >> 6;
  const int lrow = tid >> 3, lkc = tid & 7;
  const bf16* ag = A + (long)lrow * lda + lkc * 8;
  const bf16* bg = BKN ? (B + (long)(tid >> 4) * ldb + (tid & 15) * 8) : (B + (long)lrow * ldb + lkc * 8);
  const long astep = 32 * lda, bstep = BKN ? 16 * ldb : 32 * ldb;
  u32x4 xa0, xa1, xa2, xa3, xb0, xb1, xb2, xb3, ya0, ya1, ya2, ya3, yb0, yb1, yb2, yb3;
#define GT_LOAD(P_, k0)                                                  \
  {                                                                      \
    const bf16* ap_ = ag + (k0);                                         \
    P_##a0 = *(const u32x4*)(ap_); P_##a1 = *(const u32x4*)(ap_ + astep);        \
    P_##a2 = *(const u32x4*)(ap_ + a_half); P_##a3 = *(const u32x4*)(ap_ + a_half + astep); \
    const bf16* bp_ = BKN ? (bg + (long)(k0) * ldb) : (bg + (k0));       \
    P_##b0 = *(const u32x4*)(bp_); P_##b1 = *(const u32x4*)(bp_ + bstep);        \
    P_##b2 = *(const u32x4*)(bp_ + (BKN ? 2 * bstep : b_half)); P_##b3 = *(const u32x4*)(bp_ + (BKN ? 3 * bstep : b_half + bstep)); \
  }
#define GT_ST_KN(BsX, bv, i)                                             \
  {                                                                      \
    bf16* d_ = (BsX) + ((tid & 15) * 8) * S + (tid >> 4) + 16 * (i);     \
    d_[0 * S] = (bf16)(bv[0] & 0xffff); d_[1 * S] = (bf16)(bv[0] >> 16); \
    d_[2 * S] = (bf16)(bv[1] & 0xffff); d_[3 * S] = (bf16)(bv[1] >> 16); \
    d_[4 * S] = (bf16)(bv[2] & 0xffff); d_[5 * S] = (bf16)(bv[2] >> 16); \
    d_[6 * S] = (bf16)(bv[3] & 0xffff); d_[7 * S] = (bf16)(bv[3] >> 16); \
  }
  constexpr int BUFE = 2 * 128 * S;
#define GT_STORE(P_, buf)                                                                                 \
  {                                                                                                       \
    bf16* d = As + (buf) * BUFE + lrow * S + lkc * 8;                                                     \
    *(u32x4*)(d) = P_##a0; *(u32x4*)(d + 32 * S) = P_##a1; *(u32x4*)(d + 64 * S) = P_##a2; *(u32x4*)(d + 96 * S) = P_##a3; \
    if (!BKN) {                                                                                           \
      bf16* e = Bs + (buf) * BUFE + lrow * S + lkc * 8;                                                   \
      *(u32x4*)(e) = P_##b0; *(u32x4*)(e + 32 * S) = P_##b1; *(u32x4*)(e + 64 * S) = P_##b2; *(u32x4*)(e + 96 * S) = P_##b3; \
    } else {                                                                                              \
      bf16* BsB = Bs + (buf) * BUFE;                                                                      \
      GT_ST_KN(BsB, P_##b0, 0) GT_ST_KN(BsB, P_##b1, 1) GT_ST_KN(BsB, P_##b2, 2) GT_ST_KN(BsB, P_##b3, 3) \
    }                                                                                                     \
  }
#define GT_COMPUTE(buf)                                                                                   \
  {                                                                                                       \
    const bf16* ar = As + (buf) * BUFE + (wm * 64 + (lane & 15)) * S + (lane >> 4) * 8;                   \
    const bf16* br = Bs + (buf) * BUFE + (wn * 64 + (lane & 15)) * S + (lane >> 4) * 8;                   \
    _Pragma("unroll") for (int kk = 0; kk < 2; ++kk) {                                                    \
      const bf16x8 af0 = *(const bf16x8*)(ar + kk * 32), af1 = *(const bf16x8*)(ar + 16 * S + kk * 32);   \
      const bf16x8 af2 = *(const bf16x8*)(ar + 32 * S + kk * 32), af3 = *(const bf16x8*)(ar + 48 * S + kk * 32); \
      const bf16x8 bf0 = *(const bf16x8*)(br + kk * 32), bf1 = *(const bf16x8*)(br + 16 * S + kk * 32);   \
      const bf16x8 bf2 = *(const bf16x8*)(br + 32 * S + kk * 32), bf3 = *(const bf16x8*)(br + 48 * S + kk * 32); \
      acc[0][0] = MFMA16(af0, bf0, acc[0][0]); acc[0][1] = MFMA16(af0, bf1, acc[0][1]);                   \
      acc[0][2] = MFMA16(af0, bf2, acc[0][2]); acc[0][3] = MFMA16(af0, bf3, acc[0][3]);                   \
      acc[1][0] = MFMA16(af1, bf0, acc[1][0]); acc[1][1] = MFMA16(af1, bf1, acc[1][1]);                   \
      acc[1][2] = MFMA16(af1, bf2, acc[1][2]); acc[1][3] = MFMA16(af1, bf3, acc[1][3]);                   \
      acc[2][0] = MFMA16(af2, bf0, acc[2][0]); acc[2][1] = MFMA16(af2, bf1, acc[2][1]);                   \
      acc[2][2] = MFMA16(af2, bf2, acc[2][2]); acc[2][3] = MFMA16(af2, bf3, acc[2][3]);                   \
      acc[3][0] = MFMA16(af3, bf0, acc[3][0]); acc[3][1] = MFMA16(af3, bf1, acc[3][1]);                   \
      acc[3][2] = MFMA16(af3, bf2, acc[3][2]); acc[3][3] = MFMA16(af3, bf3, acc[3][3]);                   \
    }                                                                                                     \
  }
  GT_LOAD(x, 0)
  GT_LOAD(y, 64)
  __syncthreads();
  GT_STORE(x, 0)
  __syncthreads();
  for (int kt = 0; kt < nk; kt += 2) {
    if (kt + 2 < nk) GT_LOAD(x, (kt + 2) * 64)
    GT_COMPUTE(0)
    GT_STORE(y, 1)
    __syncthreads();
    if (kt + 3 < nk) GT_LOAD(y, (kt + 3) * 64)
    GT_COMPUTE(1)
    if (kt + 2 < nk) {
      GT_STORE(x, 0)
      __syncthreads();
    }
  }
#undef GT_STORE
#undef GT_COMPUTE
#undef GT_LOAD
#undef GT_ST_KN
}

DI void gemm_tile_d4(const bf16* __restrict__ A, long lda, const bf16* __restrict__ B, long ldb, int K,
                     f32x4 (&acc)[4][4], char* smem) {
  constexpr int S = 72;
  bf16* As = (bf16*)smem;
  bf16* Bs = As + 128 * S;
  const int tid = opaque_tid(), lane = tid & 63, wave = tid >> 6, wm = wave >> 1, wn = wave & 1;
  const int nk = K >> 6;
  const int lrow = tid >> 3, lkc = tid & 7;
  const bf16* ag = A + (long)lrow * lda + lkc * 8;
  const bf16* bg = B + (long)lrow * ldb + lkc * 8;
  const long astep = 32 * lda, bstep = 32 * ldb;
  u32x4 pa0, pa1, pa2, pa3, pb0, pb1, pb2, pb3, qa0, qa1, qa2, qa3, qb0, qb1, qb2, qb3, ra0, ra1, ra2, ra3, rb0, rb1, rb2, rb3;
#define G4_LOAD(P_, k0)                                                  \
  {                                                                      \
    const bf16* ap_ = ag + (k0);                                         \
    P_##a0 = *(const u32x4*)(ap_); P_##a1 = *(const u32x4*)(ap_ + astep);        \
    P_##a2 = *(const u32x4*)(ap_ + 2 * astep); P_##a3 = *(const u32x4*)(ap_ + 3 * astep); \
    const bf16* bp_ = bg + (k0);                                         \
    P_##b0 = *(const u32x4*)(bp_); P_##b1 = *(const u32x4*)(bp_ + bstep);        \
    P_##b2 = *(const u32x4*)(bp_ + 2 * bstep); P_##b3 = *(const u32x4*)(bp_ + 3 * bstep); \
  }
  constexpr int BUFE = 2 * 128 * S;
#define G4_STORE(P_, buf)                                                                                 \
  {                                                                                                       \
    bf16* d = As + (buf) * BUFE + lrow * S + lkc * 8;                                                     \
    *(u32x4*)(d) = P_##a0; *(u32x4*)(d + 32 * S) = P_##a1; *(u32x4*)(d + 64 * S) = P_##a2; *(u32x4*)(d + 96 * S) = P_##a3; \
    bf16* e = Bs + (buf) * BUFE + lrow * S + lkc * 8;                                                     \
    *(u32x4*)(e) = P_##b0; *(u32x4*)(e + 32 * S) = P_##b1; *(u32x4*)(e + 64 * S) = P_##b2; *(u32x4*)(e + 96 * S) = P_##b3; \
  }
#define G4_COMPUTE(buf)                                                                                   \
  {                                                                                                       \
    const bf16* ar = As + (buf) * BUFE + (wm * 64 + (lane & 15)) * S + (lane >> 4) * 8;                   \
    const bf16* br = Bs + (buf) * BUFE + (wn * 64 + (lane & 15)) * S + (lane >> 4) * 8;                   \
    _Pragma("unroll") for (int kk = 0; kk < 2; ++kk) {                                                    \
      const bf16x8 af0 = *(const bf16x8*)(ar + kk * 32), af1 = *(const bf16x8*)(ar + 16 * S + kk * 32);   \
      const bf16x8 af2 = *(const bf16x8*)(ar + 32 * S + kk * 32), af3 = *(const bf16x8*)(ar + 48 * S + kk * 32); \
      const bf16x8 bf0 = *(const bf16x8*)(br + kk * 32), bf1 = *(const bf16x8*)(br + 16 * S + kk * 32);   \
      const bf16x8 bf2 = *(const bf16x8*)(br + 32 * S + kk * 32), bf3 = *(const bf16x8*)(br + 48 * S + kk * 32); \
      acc[0][0] = MFMA16(af0, bf0, acc[0][0]); acc[0][1] = MFMA16(af0, bf1, acc[0][1]);                   \
      acc[0][2] = MFMA16(af0, bf2, acc[0][2]); acc[0][3] = MFMA16(af0, bf3, acc[0][3]);                   \
      acc[1][0] = MFMA16(af1, bf0, acc[1][0]); acc[1][1] = MFMA16(af1, bf1, acc[1][1]);                   \
      acc[1][2] = MFMA16(af1, bf2, acc[1][2]); acc[1][3] = MFMA16(af1, bf3, acc[1][3]);                   \
      acc[2][0] = MFMA16(af2, bf0, acc[2][0]); acc[2][1] = MFMA16(af2, bf1, acc[2][1]);                   \
      acc[2][2] = MFMA16(af2, bf2, acc[2][2]); acc[2][3] = MFMA16(af2, bf3, acc[2][3]);                   \
      acc[3][0] = MFMA16(af3, bf0, acc[3][0]); acc[3][1] = MFMA16(af3, bf1, acc[3][1]);                   \
      acc[3][2] = MFMA16(af3, bf2, acc[3][2]); acc[3][3] = MFMA16(af3, bf3, acc[3][3]);                   \
    }                                                                                                     \
  }
  G4_LOAD(p, 0)
  G4_LOAD(q, 64)
  G4_LOAD(r, 128)
  __syncthreads();
  G4_STORE(p, 0)
  if (3 < nk) G4_LOAD(p, 3 * 64)
  __syncthreads();
#define G4_STEP(j, buf, P_)                                          \
  if (kt + (j) < nk) {                                               \
    G4_COMPUTE(buf)                                                  \
    if (kt + (j) + 1 < nk) {                                         \
      G4_STORE(P_, (buf) ^ 1)                                        \
      if (kt + (j) + 4 < nk) G4_LOAD(P_, (kt + (j) + 4) * 64)        \
      __syncthreads();                                               \
    }                                                                \
  }
  for (int kt = 0; kt < nk; kt += 6) {
    G4_STEP(0, 0, q)
    G4_STEP(1, 1, r)
    G4_STEP(2, 0, p)
    G4_STEP(3, 1, q)
    G4_STEP(4, 0, r)
    G4_STEP(5, 1, p)
  }
#undef G4_STEP
#undef G4_LOAD
#undef G4_STORE
#undef G4_COMPUTE
}

#define ACC_ZERO(acc)                                                          \
  _Pragma("unroll") for (int mi_ = 0; mi_ < 4; ++mi_) _Pragma("unroll") for (int ni_ = 0; ni_ < 4; ++ni_) { \
    acc[mi_][ni_][0] = 0.f; acc[mi_][ni_][1] = 0.f; acc[mi_][ni_][2] = 0.f; acc[mi_][ni_][3] = 0.f; }

#define EPI_LOOP(acc, BODY)                                                                         \
  {                                                                                                 \
    const int tid_ = opaque_tid(); const int lane_ = tid_ & 63, wave_ = tid_ >> 6, wm_ = wave_ >> 1, wn_ = wave_ & 1; \
    _Pragma("unroll") for (int mi = 0; mi < 4; ++mi) _Pragma("unroll") for (int ni = 0; ni < 4; ++ni) \
        _Pragma("unroll") for (int r = 0; r < 4; ++r) {                                             \
      const int row = wm_ * 64 + mi * 16 + (lane_ >> 4) * 4 + r;                                    \
      const int col = wn_ * 64 + ni * 16 + (lane_ & 15);                                            \
      float v = acc[mi][ni][r];                                                                     \
      BODY                                                                                          \
    }                                                                                               \
  }

#define STAGE_ACC(acc, T)                          \
  {                                                \
    __syncthreads();                               \
    EPI_LOOP(acc, T[row * 132 + col] = v;)         \
    __syncthreads();                               \
  }
#define ROW_LOOP(T, ...)                                                                  \
  {                                                                                        \
    const int tid_r = opaque_tid();                                                        \
    const int col0 = (tid_r & 15) * 8;                                                     \
    _Pragma("unroll") for (int i_ = 0; i_ < 8; ++i_) {                                     \
      const int row = (tid_r >> 4) + 16 * i_;                                              \
      float v[8];                                                                          \
      {                                                                                    \
        const float4 a_ = *(const float4*)(T + row * 132 + col0);                          \
        const float4 b_ = *(const float4*)(T + row * 132 + col0 + 4);                      \
        v[0] = a_.x; v[1] = a_.y; v[2] = a_.z; v[3] = a_.w; v[4] = b_.x; v[5] = b_.y; v[6] = b_.z; v[7] = b_.w; \
      }                                                                                    \
      __VA_ARGS__                                                                          \
    }                                                                                      \
  }

DI void conv_t_tile(const float* __restrict__ W, int K, int N, bf16* __restrict__ WT, int tile, char* smem) {
  float* T = (float*)smem;
  const int tid = opaque_tid();
  const int ntn = N >> 6;
  const int k0 = (tile / ntn) * 64, n0 = (tile % ntn) * 64;
#pragma unroll
  for (int i = 0; i < 16; ++i) {
    int e = tid + i * 256; int kk = e >> 6, nn = e & 63;
    T[kk * 65 + nn] = W[(long)(k0 + kk) * N + n0 + nn];
  }
  __syncthreads();
#pragma unroll
  for (int i = 0; i < 16; ++i) {
    int e = tid + i * 256; int nn = e >> 6, kk = e & 63;
    WT[(long)(n0 + nn) * K + k0 + kk] = (bf16)f2bf(T[kk * 65 + nn]);
  }
  __syncthreads();
}
constexpr int CONV_ITEMS = 1536 + 384 + 256 + 512;
DI void conv_layer_item(const Params& p, int l, int it, char* smem) {
  char* ws = p.ws;
  if (it < 1536) conv_t_tile(p.w_in + (size_t)l * D * INC, D, INC, (bf16*)(ws + OFF_WIN), it, smem);
  else if (it < 1920) { int j = it - 1536; int n = j / 128;
    conv_t_tile(p.w_branch + ((size_t)l * 3 + n) * 512 * D, 512, D, (bf16*)(ws + OFF_WBR) + (size_t)n * D * 512, j % 128, smem); }
  else if (it < 2176) conv_t_tile(p.w_out + (size_t)l * D * D, D, D, (bf16*)(ws + OFF_WOUT), it - 1920, smem);
  else conv_t_tile(p.peer_w_q + (size_t)l * D * 2048, D, 2048, (bf16*)(ws + OFF_WQ), it - 2176, smem);
}
DI void conv_e_item(const float* __restrict__ src, bf16* __restrict__ dst, int it) {
  size_t o = (size_t)it * 2048 + opaque_tid() * 8;
  float4 a = *(const float4*)(src + o), b = *(const float4*)(src + o + 4);
  uint4 u; u.x = pk2(a.x, a.y); u.y = pk2(a.z, a.w); u.z = pk2(b.x, b.y); u.w = pk2(b.z, b.w);
  *(uint4*)(dst + o) = u;
}

DI void load_row_f32(const float* __restrict__ src, int lane, float* v) {
  float4 a = *(const float4*)(src + lane * 8), b = *(const float4*)(src + lane * 8 + 4);
  float4 c = *(const float4*)(src + 512 + lane * 8), d = *(const float4*)(src + 512 + lane * 8 + 4);
  v[0] = a.x; v[1] = a.y; v[2] = a.z; v[3] = a.w; v[4] = b.x; v[5] = b.y; v[6] = b.z; v[7] = b.w;
  v[8] = c.x; v[9] = c.y; v[10] = c.z; v[11] = c.w; v[12] = d.x; v[13] = d.y; v[14] = d.z; v[15] = d.w;
}
DI void store_row_f32(float* __restrict__ dst, int lane, const float* v) {
  *(float4*)(dst + lane * 8) = make_float4(v[0], v[1], v[2], v[3]);
  *(float4*)(dst + lane * 8 + 4) = make_float4(v[4], v[5], v[6], v[7]);
  *(float4*)(dst + 512 + lane * 8) = make_float4(v[8], v[9], v[10], v[11]);
  *(float4*)(dst + 512 + lane * 8 + 4) = make_float4(v[12], v[13], v[14], v[15]);
}
DI void normmod_store(const float* v, const float* __restrict__ g, const float* __restrict__ shift,
                      const float* __restrict__ scale, bf16* __restrict__ dst, int lane) {
  float ss = 0.f;
#pragma unroll
  for (int e = 0; e < 16; ++e) ss += v[e] * v[e];
  ss = wave_sum(ss);
  const float rn = rsqrtf(ss * (1.0f / 1024.0f) + EPS);
  float gg[16], sh[16], sc[16], o[16];
  load_row_f32(g, lane, gg); load_row_f32(shift, lane, sh); load_row_f32(scale, lane, sc);
#pragma unroll
  for (int e = 0; e < 16; ++e) o[e] = v[e] * rn * gg[e] * (1.0f + sc[e]) + sh[e];
  *(uint4*)(dst + lane * 8) = pack8(o);
  *(uint4*)(dst + 512 + lane * 8) = pack8(o + 8);
}

DI void load_row16_f32(const float* __restrict__ src, int lane, float* v) {
#pragma unroll
  for (int i = 0; i < 4; ++i) {
    float4 a = *(const float4*)(src + lane * 16 + i * 4);
    v[4 * i] = a.x; v[4 * i + 1] = a.y; v[4 * i + 2] = a.z; v[4 * i + 3] = a.w;
  }
}
DI void store_row16_f32(float* __restrict__ dst, int lane, const float* v) {
#pragma unroll
  for (int i = 0; i < 4; ++i) *(float4*)(dst + lane * 16 + i * 4) = make_float4(v[4 * i], v[4 * i + 1], v[4 * i + 2], v[4 * i + 3]);
}
DI void normmod_store16(const float* v, const float* __restrict__ g, const float* __restrict__ shift,
                        const float* __restrict__ scale, bf16* __restrict__ dst, int lane) {
  float ss = 0.f;
#pragma unroll
  for (int e = 0; e < 16; ++e) ss += v[e] * v[e];
  ss = wave_sum(ss);
  const float rn = rsqrtf(ss * (1.0f / 1024.0f) + EPS);
  float gg[16], sh[16], sc[16], o[16];
  load_row16_f32(g, lane, gg); load_row16_f32(shift, lane, sh); load_row16_f32(scale, lane, sc);
#pragma unroll
  for (int e = 0; e < 16; ++e) o[e] = v[e] * rn * gg[e] * (1.0f + sc[e]) + sh[e];
  *(uint4*)(dst + lane * 16) = pack8(o);
  *(uint4*)(dst + lane * 16 + 8) = pack8(o + 8);
}
DI void conv_fp8_row(const float* __restrict__ src, unsigned char* __restrict__ dst, float* __restrict__ sc, int lane) {
  float v[16];
  load_row16_f32(src, lane, v);
  float m = 0.f;
#pragma unroll
  for (int e = 0; e < 16; ++e) m = fmaxf(m, fabsf(v[e]));
#pragma unroll
  for (int o = 32; o >= 1; o >>= 1) m = fmaxf(m, shx(m, o, lane));
  const float s = m > 0.f ? 384.0f / m : 1.0f;
  u32x4 q;
#pragma unroll
  for (int w = 0; w < 4; ++w) {
    int x = 0;
    x = __builtin_amdgcn_cvt_pk_fp8_f32(v[4 * w] * s, v[4 * w + 1] * s, x, false);
    x = __builtin_amdgcn_cvt_pk_fp8_f32(v[4 * w + 2] * s, v[4 * w + 3] * s, x, true);
    q[w] = (unsigned)x;
  }
  *(u32x4*)(dst + lane * 16) = q;
  if (lane == 0) *sc = m > 0.f ? m * (1.0f / 384.0f) : 1.0f;
}
DI void conv_fp8_row2(const float* __restrict__ src, unsigned char* __restrict__ dst, float* __restrict__ sc, int lane) {
  float v[2][16];
  load_row16_f32(src, lane, v[0]);
  load_row16_f32(src + D, lane, v[1]);
#pragma unroll
  for (int rr = 0; rr < 2; ++rr) {
    float m = 0.f;
#pragma unroll
    for (int e = 0; e < 16; ++e) m = fmaxf(m, fabsf(v[rr][e]));
#pragma unroll
    for (int o = 32; o >= 1; o >>= 1) m = fmaxf(m, shx(m, o, lane));
    const float s = m > 0.f ? 384.0f / m : 1.0f;
    u32x4 q;
#pragma unroll
    for (int w = 0; w < 4; ++w) {
      int x = 0;
      x = __builtin_amdgcn_cvt_pk_fp8_f32(v[rr][4 * w] * s, v[rr][4 * w + 1] * s, x, false);
      x = __builtin_amdgcn_cvt_pk_fp8_f32(v[rr][4 * w + 2] * s, v[rr][4 * w + 3] * s, x, true);
      q[w] = (unsigned)x;
    }
    *(u32x4*)(dst + (size_t)rr * D + lane * 16) = q;
    if (lane == 0) sc[rr] = m > 0.f ? m * (1.0f / 384.0f) : 1.0f;
  }
}
DI float dot16_fp8(u32x4 q, const float* hv) {
  float s = 0.f;
#pragma unroll
  for (int w = 0; w < 4; ++w) {
    const f32x2_t lo = __builtin_amdgcn_cvt_pk_f32_fp8((int)q[w], false), hi = __builtin_amdgcn_cvt_pk_f32_fp8((int)q[w], true);
    s += lo[0] * hv[4 * w] + lo[1] * hv[4 * w + 1] + hi[0] * hv[4 * w + 2] + hi[1] * hv[4 * w + 3];
  }
  return s;
}
DI void axpy16_fp8(u32x4 q, float w_, float* o) {
#pragma unroll
  for (int w = 0; w < 4; ++w) {
    const f32x2_t lo = __builtin_amdgcn_cvt_pk_f32_fp8((int)q[w], false), hi = __builtin_amdgcn_cvt_pk_f32_fp8((int)q[w], true);
    o[4 * w] += w_ * lo[0]; o[4 * w + 1] += w_ * lo[1]; o[4 * w + 2] += w_ * hi[0]; o[4 * w + 3] += w_ * hi[1];
  }
}

DI int key_row(int b, int kb, int j) { return kb < 4 ? NLAT + b * LC + kb * 64 + j : b * SEQ + (kb - 4) * 64 + j; }

DI void attn_map(const bf16* __restrict__ Ksm, const bf16* __restrict__ Vsk, bf16x8 q0, bf16x8 q1, bf16x8 q2, bf16x8 q3, int pc, int c, int hh,
                 f32x16& O0, f32x16& O1, f32x16& O2, f32x16& O3, float negc, float& lrun) {
  f32x16 X0;
#pragma unroll
  for (int i = 0; i < 16; ++i) X0[i] = negc;
  {
    const bf16* kr = Ksm + pc * 136 + hh * 8;
    X0 = MFMA32(*(const bf16x8*)(kr), q0, X0);
    X0 = MFMA32(*(const bf16x8*)(kr + 16), q1, X0);
    X0 = MFMA32(*(const bf16x8*)(kr + 32), q2, X0);
    X0 = MFMA32(*(const bf16x8*)(kr + 48), q3, X0);
  }
  float ls = 0.f;
  if (__any(negc < 0.f)) {
#pragma unroll
    for (int i = 0; i < 16; ++i) { X0[i] = __builtin_amdgcn_exp2f(X0[i]); ls += X0[i]; }
  }
  lrun += ls;
  u32x4 u00, u01;
  u00[0] = pk2(X0[0], X0[1]); u00[1] = pk2(X0[2], X0[3]); u00[2] = pk2(X0[4], X0[5]); u00[3] = pk2(X0[6], X0[7]);
  u01[0] = pk2(X0[8], X0[9]); u01[1] = pk2(X0[10], X0[11]); u01[2] = pk2(X0[12], X0[13]); u01[3] = pk2(X0[14], X0[15]);
  const bf16x8 p00 = __builtin_bit_cast(bf16x8, u00), p01 = __builtin_bit_cast(bf16x8, u01);
  const bf16* vr = Vsk + c * 72 + hh * 8;
#define PV_STEP(pf, off)                                                                    \
  {                                                                                         \
    const bf16x8 v0 = *(const bf16x8*)(vr + (off)), v1 = *(const bf16x8*)(vr + 32 * 72 + (off)); \
    O0 = MFMA32(v0, pf, O0); O1 = MFMA32(v1, pf, O1);                                        \
    const bf16x8 v2 = *(const bf16x8*)(vr + 64 * 72 + (off)), v3 = *(const bf16x8*)(vr + 96 * 72 + (off)); \
    O2 = MFMA32(v2, pf, O2); O3 = MFMA32(v3, pf, O3);                                        \
  }
  PV_STEP(p00, 0) PV_STEP(p01, 16)
#undef PV_STEP
  __builtin_amdgcn_sched_barrier(0);
}

DI void attn_item(const Params& p, int layer_in, int b, int h, int q_row0, int nkb, char* smem) {
  const bf16* P = (const bf16*)(p.ws + OFF_P);
  const bf16* VT = (const bf16*)(p.ws + OFF_VT);
  bf16* BR = (bf16*)(p.ws + OFF_BR);
  bf16* Ks = (bf16*)smem;
  bf16* Vs = Ks + 64 * 136;
  bf16* Qs = Vs + 128 * 72;
  int layer = layer_in;
  int tid = opaque_tid();
  __syncthreads();
  const int lane = tid & 63, wave = tid >> 6;
  const int c = lane & 31, hh = lane >> 5;
  const int pc = (c & ~12) | ((c & 4) << 1) | ((c & 8) >> 1);
  const bf16* qgp = P + (long)(q_row0 + wave * 32 + c) * INC + h * 128 + hh * 8;
  const bf16x8 qa0 = *(const bf16x8*)(qgp), qa1 = *(const bf16x8*)(qgp + 16), qa2 = *(const bf16x8*)(qgp + 32), qa3 = *(const bf16x8*)(qgp + 48);
  const bf16x8 qb0 = *(const bf16x8*)(qgp + 64), qb1 = *(const bf16x8*)(qgp + 80), qb2 = *(const bf16x8*)(qgp + 96), qb3 = *(const bf16x8*)(qgp + 112);
  f32x16 O00, O01, O02, O03, O10, O11, O12, O13;
#pragma unroll
  for (int i = 0; i < 16; ++i) { O00[i] = 0.f; O01[i] = 0.f; O02[i] = 0.f; O03[i] = 0.f; O10[i] = 0.f; O11[i] = 0.f; O12[i] = 0.f; O13[i] = 0.f; }
  float l0r = 0.f, l1r = 0.f;
  float negc;
  {
    const float* gq = p.q_norm_g + layer * 64; const float* gk = p.k_norm_g + layer * 64;
    float mq = 0.f, mk = 0.f;
    for (int i = 0; i < 64; ++i) { mq = fmaxf(mq, fabsf(gq[i])); mk = fmaxf(mk, fabsf(gk[i])); }
    negc = -(8.0f * 1.4426950408889634f * 1.02f) * mq * mk;
  }

  const int kpart = tid & 15, kkey = tid >> 4;
  const int vpart = tid & 7, vdv = tid >> 3;
  u32x4 k0, k1, k2, k3;
#define AT_LOADK(kb_)                                                                                    \
  {                                                                                                      \
    const bf16* kg = P + (long)key_row(b, (kb_), kkey) * INC + 512 + h * 128 + kpart * 8;                \
    k0 = *(const u32x4*)(kg); k1 = *(const u32x4*)(kg + 16 * INC); k2 = *(const u32x4*)(kg + 32 * INC); k3 = *(const u32x4*)(kg + 48 * INC); \
  }
  AT_LOADK(0)
  for (int kb = 0; kb < nkb; ++kb) {
    const bf16* vg = VT + ((long)(b * 4 + h) * 128 + vdv) * LK + kb * 64 + vpart * 8;
    const u32x4 v0 = *(const u32x4*)(vg), v1 = *(const u32x4*)(vg + 32 * LK), v2 = *(const u32x4*)(vg + 64 * LK), v3 = *(const u32x4*)(vg + 96 * LK);
    __syncthreads();
    {
      bf16* d = Ks + kkey * 136 + kpart * 8;
      *(u32x4*)(d) = k0; *(u32x4*)(d + 16 * 136) = k1; *(u32x4*)(d + 32 * 136) = k2; *(u32x4*)(d + 48 * 136) = k3;
      bf16* e = Vs + vdv * 72 + vpart * 8;
      *(u32x4*)(e) = v0; *(u32x4*)(e + 32 * 72) = v1; *(u32x4*)(e + 64 * 72) = v2; *(u32x4*)(e + 96 * 72) = v3;
    }
    __syncthreads();
    if (kb + 1 < nkb) AT_LOADK(kb + 1)
    attn_map(Ks, Vs, qa0, qa1, qa2, qa3, pc, c, hh, O00, O01, O02, O03, negc, l0r);
    attn_map(Ks + 64, Vs, qb0, qb1, qb2, qb3, pc, c, hh, O10, O11, O12, O13, negc, l1r);
    attn_map(Ks + 32 * 136, Vs + 32, qa0, qa1, qa2, qa3, pc, c, hh, O00, O01, O02, O03, negc, l0r);
    attn_map(Ks + 32 * 136 + 64, Vs + 32, qb0, qb1, qb2, qb3, pc, c, hh, O10, O11, O12, O13, negc, l1r);
  }
#undef AT_LOADK
  asm volatile("" : "+s"(layer));
  const float* lp = p.lam_params + layer * 256;
  float d01 = 0.f, d23 = 0.f;
  for (int i = 0; i < 64; ++i) { d01 += lp[i] * lp[64 + i]; d23 += lp[128 + i] * lp[192 + i]; }
  const float lam_init = 0.8f - 0.6f * expf(-0.3f * (float)layer);
  const float lam = expf(d01) - expf(d23) + lam_init;
  const float l0 = l0r + shx(l0r, 32, lane), l1 = l1r + shx(l1r, 32, lane);
  const float i0 = 1.0f / l0, i1 = lam / l1;
  float ss = 0.f;
#pragma unroll
  for (int i = 0; i < 16; ++i) {
    O00[i] = O00[i] * i0 - O10[i] * i1; O01[i] = O01[i] * i0 - O11[i] * i1;
    O02[i] = O02[i] * i0 - O12[i] * i1; O03[i] = O03[i] * i0 - O13[i] * i1;
    ss += O00[i] * O00[i] + O01[i] * O01[i] + O02[i] * O02[i] + O03[i] * O03[i];
  }
  ss += shx(ss, 32, lane);
  const float rn = rsqrtf(ss * (1.0f / 128.0f) + EPS) * (1.0f - lam_init);
  const float* sg = p.subln_g + layer * 128;
  __syncthreads();
  int tid2 = opaque_tid();
  const int c2 = tid2 & 31, hh2 = (tid2 >> 5) & 1, wave2 = tid2 >> 6;
  bf16* Os = (bf16*)smem;
  bf16* orow = Os + (wave2 * 32 + c2) * 136;
#pragma unroll
  for (int i = 0; i < 16; ++i) {
    const int dv = (i & 3) + 8 * (i >> 2) + 4 * hh2;
    orow[dv] = (bf16)f2bf(O00[i] * rn * sg[dv]);
    orow[32 + dv] = (bf16)f2bf(O01[i] * rn * sg[32 + dv]);
    orow[64 + dv] = (bf16)f2bf(O02[i] * rn * sg[64 + dv]);
    orow[96 + dv] = (bf16)f2bf(O03[i] * rn * sg[96 + dv]);
  }
  __syncthreads();
  {
    const int row = tid2 >> 4, part = tid2 & 15;
    bf16* og = BR + (long)(q_row0 + row) * 1536 + h * 128 + part * 8;
    const bf16* os = Os + row * 136 + part * 8;
#pragma unroll
    for (int i = 0; i < 8; ++i) *(u32x4*)(og + (long)i * 16 * 1536) = *(const u32x4*)(os + i * 16 * 136);
  }
  __syncthreads();
}

DI float med3f(float a, float b, float c) { return __builtin_amdgcn_fmed3f(a, b, c); }
#define TK_INS(V, xv)                                                            \
  {                                                                              \
    const float x_ = (xv);                                                       \
    _Pragma("unroll") for (int j_ = 15; j_ >= 1; --j_) V[j_] = med3f(V[j_ - 1], x_, V[j_]); \
    V[0] = fmaxf(V[0], x_);                                                      \
  }
#define TK_INSERT(V, I, xv, xi)                                          \
  {                                                                      \
    float x_ = (xv); int i_ = (xi);                                      \
    _Pragma("unroll") for (int j_ = 0; j_ < 16; ++j_) {                  \
      const bool gt_ = x_ > V[j_];                                       \
      const float tv_ = gt_ ? x_ : V[j_]; const int ti_ = gt_ ? i_ : I[j_]; \
      x_ = gt_ ? V[j_] : x_; i_ = gt_ ? I[j_] : i_;                      \
      V[j_] = tv_; I[j_] = ti_;                                          \
    }                                                                    \
  }
DI unsigned f2key(float x, unsigned tag, unsigned mask) {
  const unsigned b = __float_as_uint(x);
  const unsigned k = b ^ ((unsigned)((int)b >> 31) | 0x80000000u);
  return (k & ~mask) | tag;
}
DI float key2f(unsigned k, unsigned mask) {
  k &= ~mask;
  const unsigned b = k ^ ((k & 0x80000000u) ? 0x80000000u : 0xffffffffu);
  return __uint_as_float(b);
}
DI unsigned umed3(unsigned a, unsigned b, unsigned c) { return max(min(a, b), min(max(a, b), c)); }
#define TK_INSU(V, xv)                                                           \
  {                                                                              \
    const unsigned x_ = (xv);                                                    \
    _Pragma("unroll") for (int j_ = 15; j_ >= 1; --j_) V[j_] = umed3(V[j_ - 1], x_, V[j_]); \
    V[0] = max(V[0], x_);                                                        \
  }
#define TK_INS2(V, I, xv, xi)                                                    \
  {                                                                              \
    const float x_ = (xv); const int i_ = (xi);                                  \
    bool g_[16];                                                                 \
    _Pragma("unroll") for (int j_ = 0; j_ < 16; ++j_) g_[j_] = x_ > V[j_];       \
    _Pragma("unroll") for (int j_ = 15; j_ >= 1; --j_) {                         \
      I[j_] = g_[j_] ? (g_[j_ - 1] ? I[j_ - 1] : i_) : I[j_];                    \
      V[j_] = g_[j_] ? (g_[j_ - 1] ? V[j_ - 1] : x_) : V[j_];                    \
    }                                                                            \
    I[0] = g_[0] ? i_ : I[0]; V[0] = g_[0] ? x_ : V[0];                          \
  }
DI float tag_bits(float x, unsigned tag, unsigned mask) { return __uint_as_float((__float_as_uint(x) & ~mask) | tag); }

DI void peer_list(const bf16* __restrict__ qa, const bf16* __restrict__ keys, char* smem, float (&so)[16], int (&io)[16]) {
  const int tid = opaque_tid();
  const int t = tid & 127, half = tid >> 7;
  float* S = (float*)smem;
  float* XH = (float*)smem;
  {
    f32x4 acc[4][4];
    ACC_ZERO(acc)
    gemm_tile<128, 128, false>(qa, 2048, keys, 128, 128, acc, smem);
    __syncthreads();
    EPI_LOOP(acc, S[row * 129 + col] = v;)
  }
  __syncthreads();
  unsigned V[16];
#pragma unroll
  for (int j = 0; j < 16; ++j) V[j] = 0u;
  {
    const float* sr = S + t * 129 + half * 64;
#pragma unroll 4
    for (int k = 0; k < 64; ++k) TK_INSU(V, f2key(sr[k], 127u - (unsigned)(half * 64 + k), 127u))
  }
  __syncthreads();
  unsigned* XHU = (unsigned*)smem;
  if (half == 1) {
#pragma unroll
    for (int j = 0; j < 16; ++j) XHU[t * 17 + j] = V[j];
  }
  __syncthreads();
  if (half == 0) {
#pragma unroll
    for (int j = 0; j < 16; ++j) TK_INSU(V, XHU[t * 17 + j])
    float ss = 0.f;
#pragma unroll
    for (int i = 0; i < 16; ++i) {
      float f[8];
      unpack8(*(const uint4*)(qa + (size_t)t * 2048 + i * 8), f);
#pragma unroll
      for (int e = 0; e < 8; ++e) ss += f[e] * f[e];
    }
    const float rn = rsqrtf(ss * (1.0f / 128.0f) + EPS);
#pragma unroll
    for (int j = 0; j < 16; ++j) { io[j] = 127 - (int)(V[j] & 127u); so[j] = key2f(V[j], 127u) * rn; }
  } else {
#pragma unroll
    for (int j = 0; j < 16; ++j) { io[j] = 0; so[j] = 0.f; }
  }
  __syncthreads();
}

#define LAS __attribute__((address_space(3)))
#define XB_TMO      128
#define XB_XCNT(j)  (256  + 64 * (j))
#define XB_XSUB(j)  (1280 + 64 * (j))
#define XB_XGEN(j)  (2304 + 64 * (j))
#define XB_TOP      3328
#define XB_TOPGEN   3392
#define XCD_BAR_WORDS 3456
#define XB_SPIN_CAP (1u << 21)
DI unsigned xb_ld(unsigned* p) { return __hip_atomic_load(p, __ATOMIC_RELAXED, __HIP_MEMORY_SCOPE_AGENT); }
DI unsigned xb_add(unsigned* p, unsigned v) { return __hip_atomic_fetch_add(p, v, __ATOMIC_RELAXED, __HIP_MEMORY_SCOPE_AGENT); }
DI unsigned xb_xcc_id() { return (unsigned)__builtin_amdgcn_s_getreg((3 << 11) | 20) & 0xFu; }
#define XB_SPIN(cond, bar) do { unsigned _sp = 0; while (cond) { __builtin_amdgcn_s_sleep(1); \
    if ((++_sp & 255u) == 0u) { if (xb_ld(&(bar)[XB_TMO])) break; if (_sp > XB_SPIN_CAP) { atomicAdd(&(bar)[XB_TMO], 1u); break; } } } } while (0)
struct XcdBarrier { unsigned* bar; unsigned x; volatile LAS unsigned* st; };
DI XcdBarrier xcd_barrier_post(unsigned* bar, volatile LAS unsigned* st) {
  XcdBarrier b; b.bar = bar; b.x = xb_xcc_id(); b.st = st;
  if (threadIdx.x == 0) (void)xb_add(&bar[XB_XCNT(b.x)], 1u);
  return b;
}
DI void xcd_barrier_complete(unsigned* bar, unsigned x, unsigned& nloc, unsigned& nx) {
  const unsigned G = gridDim.x * gridDim.y * gridDim.z;
  unsigned sum, cnt, mine, sp = 0u;
  for (;;) {
    sum = 0u; cnt = 0u; mine = 0u;
#pragma unroll
    for (unsigned j = 0; j < 16; ++j) { const unsigned c = xb_ld(&bar[XB_XCNT(j)]); sum += c; cnt += (c > 0u) ? 1u : 0u; mine = (j == x) ? c : mine; }
    if (sum == G) break;
    __builtin_amdgcn_s_sleep(1);
    if ((++sp & 255u) == 0u) { if (xb_ld(&bar[XB_TMO])) break; if (sp > XB_SPIN_CAP) { atomicAdd(&bar[XB_TMO], 1u); break; } }
  }
  nloc = mine > 0u ? mine : 1u; nx = cnt > 0u ? cnt : 1u;
}
DI void xcd_barrier(const XcdBarrier& b) {
  asm volatile("s_waitcnt vmcnt(0)" ::: "memory");
  __syncthreads();
  if (threadIdx.x == 0) {
    unsigned* bar = b.bar;
    __builtin_amdgcn_s_waitcnt(0);
    unsigned nloc = b.st[0], nx = b.st[1];
    if (nloc == 0u) { xcd_barrier_complete(bar, b.x, nloc, nx); b.st[0] = nloc; b.st[1] = nx; }
    const unsigned old = xb_add(&bar[XB_XSUB(b.x)], 1u);
    const unsigned gen = old / nloc;
    if (old + 1u == (gen + 1u) * nloc) {
      __builtin_amdgcn_fence(__ATOMIC_RELEASE, "agent");
      asm volatile("s_waitcnt vmcnt(0)" ::: "memory");
      const unsigned og = xb_add(&bar[XB_TOP], 1u);
      const unsigned tg = og / nx;
      if (og + 1u == (tg + 1u) * nx) xb_add(&bar[XB_TOPGEN], 1u);
      else XB_SPIN(xb_ld(&bar[XB_TOPGEN]) == tg, bar);
      __builtin_amdgcn_fence(__ATOMIC_ACQUIRE, "agent");
      xb_add(&bar[XB_XGEN(b.x)], 1u);
      asm volatile("s_waitcnt vmcnt(0)" ::: "memory");
    } else {
      XB_SPIN(xb_ld(&bar[XB_XGEN(b.x)]) == gen, bar);
      __builtin_amdgcn_fence(__ATOMIC_ACQUIRE, "agent");
      asm volatile("s_waitcnt vmcnt(0)" ::: "memory");
    }
  }
  __syncthreads();
}

#define DYN_BEGIN(N_)                                                                       \
  {                                                                                         \
    unsigned* wq_ = (unsigned*)(ws + OFF_BAR) + 3584 + KIND + 16 * layer;                   \
    volatile LAS unsigned* nx_ = (volatile LAS unsigned*)(smem + LDS_BYTES) + 2;            \
    int it = bid;                                                                           \
    while (it < (N_)) {                                                                     \
      unsigned nxt_ = 0u;                                                                   \
      if (tid == 0) nxt_ = (unsigned)G + __hip_atomic_fetch_add(wq_, 1u, __ATOMIC_RELAXED, __HIP_MEMORY_SCOPE_AGENT);
#define DYN_END()                                                                           \
      __syncthreads();                                                                      \
      if (tid == 0) *nx_ = nxt_;                                                            \
      __syncthreads();                                                                      \
      it = (int)*nx_;                                                                       \
    }                                                                                       \
  }

constexpr int N_PHASES = 3 + 10 * DEPTH;

template <int KIND>
DI void phase_body(const Params& p, int layer, char* smem) {
  char* ws = p.ws;
  const int tid = opaque_tid(), lane = tid & 63, wave = tid >> 6;
  const int G = gridDim.x, bid = opaque_bid();
  float* X = (float*)(ws + OFF_X);
  bf16* HB = (bf16*)(ws + OFF_HB);
  bf16* P = (bf16*)(ws + OFF_P);
  const float* MOD = (const float*)(ws + OFF_MOD);

  if constexpr (KIND == 0) {
    constexpr int N_MODP = DEPTH * 24 * 8;
    constexpr int N_KEYS = DEPTH * 8 * 2 * 128 * 128 / 2048;
    constexpr int N_WS = DEPTH * 4 * 128 * 128 / 2048;
    constexpr int N_DL = 67, N_DC = 256, N_FC = 16, N_ROPE = 1;
    constexpr int E0 = N_MODP, E1 = E0 + CONV_ITEMS, E2 = E1 + N_KEYS, E3 = E2 + N_WS, E4 = E3 + N_DL, E5 = E4 + N_DC,
                  E6 = E5 + N_FC, E7 = E6 + N_ROPE;
    for (int it = bid; it < E7; it += G) {
      if (it < E0) {
        const int l = it / 192, rem = it % 192, cb = rem >> 3, kc = rem & 7;
        float* cs = (float*)smem;
        for (int i = tid; i < 9 * 128; i += 256) {
          int r = i >> 7, k = i & 127;
          float cv = (r < 8) ? p.c[r * D + kc * 128 + k] : p.c_ctx[kc * 128 + k];
          cs[i] = cv / (1.0f + expf(-cv));
        }
        __syncthreads();
        const int col = cb * 256 + tid;
        float a[9];
#pragma unroll
        for (int r = 0; r < 9; ++r) a[r] = 0.f;
        const float* w = p.w_ada + ((size_t)l * D + kc * 128) * INC + col;
#pragma unroll 4
        for (int k = 0; k < 128; ++k) {
          const float wv = w[(size_t)k * INC];
#pragma unroll
          for (int r = 0; r < 9; ++r) a[r] += cs[r * 128 + k] * wv;
        }
        float* mp = (float*)(ws + OFF_MODP) + ((size_t)(l * 8 + kc) * 9) * INC + col;
#pragma unroll
        for (int r = 0; r < 9; ++r) mp[(size_t)r * INC] = a[r];
        __syncthreads();
      } else if (it < E1) {
        conv_layer_item(p, 0, it - E0, smem);
      } else if (it < E2) {
        conv_e_item(p.peer_sub_keys, (bf16*)(ws + OFF_KEYS), it - E1);
      } else if (it < E3) {
        conv_e_item(p.cm_w_s, (bf16*)(ws + OFF_WS), it - E2);
      } else if (it < E4) {
        const int j = it - E3;
        for (int e8 = tid; e8 < 64 * 16; e8 += 256) {
          const int rr = e8 >> 4, c0 = (e8 & 15) * 8;
          float f[8];
          bf16* dst;
          if (j < 2) {
            const int row = j * 64 + rr; const int rip = row >> 6, s1 = row & 63;
#pragma unroll
            for (int e = 0; e < 8; ++e) {
              const int col = c0 + e; const int ri = col >> 6, t1 = col & 63;
              const float rev = (float)((s1 * t1) & 63) * (1.0f / 64.0f);
              const float cv = cos_rev(rev), sv = sin_rev(rev);
              f[e] = (rip == ri) ? cv : (rip == 0 ? sv : -sv);
            }
            dst = (bf16*)(ws + OFF_M1) + (size_t)row * 128 + c0;
          } else {
            const int row = (j - 2) * 64 + rr; const int s1 = row >> 6, s2 = row & 63; const int sfull = s1 + 64 * s2;
#pragma unroll
            for (int e = 0; e < 8; ++e) {
              const int col = c0 + e; const int rip = col >> 6, t2 = col & 63;
              const float rev = (float)((t2 * sfull) & 4095) * (1.0f / 4096.0f);
              f[e] = rip ? sin_rev(rev) : cos_rev(rev);
            }
            dst = (bf16*)(ws + OFF_M2) + (size_t)row * 128 + c0;
          }
          *(uint4*)dst = pack8(f);
        }
      } else if (it < E5) {
        const int s = it - E4;
        bf16* dc = (bf16*)(ws + OFF_DC) + (size_t)s * 512;
        if (tid < 64) {
          float f[8];
#pragma unroll
          for (int e = 0; e < 8; ++e) {
            const int j = tid * 8 + e; const int ri = j >> 8, t = j & 255;
            const float rev = (float)((s * t) & 255) * (1.0f / 256.0f);
            f[e] = ri ? sin_rev(rev) : cos_rev(rev);
          }
          *(uint4*)(dc + tid * 8) = pack8(f);
        }
      } else if (it < E6) {
        const int base = (it - E5) * 2048 + tid * 8;
        float f[8];
#pragma unroll
        for (int e = 0; e < 8; ++e) {
          const int idx = base + e; const int n = idx >> 7, cc = idx & 127; const int ri = n >> 7, kk = n & 127;
          const float rev = (float)((cc * kk) & 127) * (1.0f / 128.0f);
          f[e] = ri ? -sin_rev(rev) : cos_rev(rev);
        }
        *(uint4*)((bf16*)(ws + OFF_FC) + base) = pack8(f);
      } else {
        float* rope = (float*)(ws + OFF_ROPE);
        for (int i = tid; i < 64 * 16; i += 256) {
          const int pos = i >> 4, fi = i & 15;
          const float freq = exp2f(-(float)fi * (1.0f / 16.0f) * 13.287712379549449f);
          const float ang = (float)pos * freq;
          float rev = ang * 0.15915494309189535f;
          rev -= floorf(rev);
          rope[i * 2] = cos_rev(rev);
          rope[i * 2 + 1] = sin_rev(rev);
        }
      }
    }
    return;
  }
  if constexpr (KIND == 1) {
    const float* mp = (const float*)(ws + OFF_MODP);
    float* mo = (float*)(ws + OFF_MOD);
    for (int i = bid * 256 + tid; i < DEPTH * 9 * INC; i += G * 256) {
      const int l = i / (9 * INC), rem = i % (9 * INC), col = rem % INC;
      float s = p.b_ada[l * INC + col];
#pragma unroll
      for (int kc = 0; kc < 8; ++kc) s += mp[(size_t)(l * 8 + kc) * 9 * INC + rem];
      mo[i] = s;
    }
    return;
  }
  if constexpr (KIND == 2) {
    for (int it = bid; it < MROWS / 4; it += G) {
      const int r = it * 4 + wave;
      const bool isc = r >= NLAT;
      const float* src = isc ? p.ctx + (size_t)(r - NLAT) * D : p.x + (size_t)r * D;
      const int brow = isc ? 8 : r / SEQ;
      float v[16];
      load_row_f32(src, lane, v);
      store_row_f32(X + (size_t)r * D, lane, v);
      const float* m = MOD + (size_t)(0 * 9 + brow) * INC;
      normmod_store(v, p.norm1_g, m, m + D, HB + (size_t)r * D, lane);
    }
    return;
  }
  const float* MODL = MOD + (size_t)layer * 9 * INC;
  const int MTL = (layer == DEPTH - 1) ? NLAT / 128 : MT;

  if constexpr (KIND == 3) {
    const bf16* W = (const bf16*)(ws + OFF_WIN);
    for (int it = bid; it < MT * 48; it += G) {
      const int mt = it / 48, nt = it % 48;
      f32x4 acc[4][4];
      ACC_ZERO(acc)
      gemm_tile_d4(HB + (size_t)mt * 128 * D, D, W + (size_t)nt * 128 * D, D, D, acc, smem);
      bf16* out = P + (size_t)mt * 128 * INC + nt * 128;
      float* T = (float*)smem;
      STAGE_ACC(acc, T)
      ROW_LOOP(T, *(uint4*)(out + (size_t)row * INC + col0) = pack8(v);)
    }
    return;
  }
  if constexpr (KIND == 4) {
    const float* rope = (const float*)(ws + OFF_ROPE);
    const float* qg = p.q_norm_g + layer * 64;
    const float* kg = p.k_norm_g + layer * 64;
    const float* lng = p.cm_ln_g + layer * 512;
    constexpr int NA = MROWS / 4, NBt = NB * 68 * 4, NC = NB * 4 * 2 * 32 + 16 * 4 * 2;
    for (int it = bid; it < NA + NBt + NC; it += G) {
      if (it < NA) {
        const int r = it * 4 + wave;
        const bool isc = r >= NLAT;
        const int t = r & (SEQ - 1);
        bf16* pr = P + (size_t)r * INC;
        const int j = lane & 7;
        const int pos = (j < 4) ? (t >> 6) : (t & 63);
        const uint4 rq_ = *(const uint4*)(pr + lane * 8), rk_ = *(const uint4*)(pr + 512 + lane * 8);
        const uint4 ru_ = *(const uint4*)(pr + 1536 + lane * 8), rv_ = *(const uint4*)(pr + 2048 + lane * 8);
        float cs[8], sn[8];
#pragma unroll
        for (int e = 0; e < 8; ++e) {
          const int fi = (j & 1) * 8 + e;
          cs[e] = rope[(pos * 16 + fi) * 2]; sn[e] = rope[(pos * 16 + fi) * 2 + 1];
        }
#pragma unroll
        for (int qk = 0; qk < 2; ++qk) {
          const float* g = qk ? kg : qg;
          float v[8];
          unpack8(qk ? rk_ : rq_, v);
          float ss = 0.f;
#pragma unroll
          for (int e = 0; e < 8; ++e) ss += v[e] * v[e];
          ss += shx(ss, 1, lane); ss += shx(ss, 2, lane); ss += shx(ss, 4, lane);
          const float rn = rsqrtf(ss * (1.0f / 64.0f) + EPS);
#pragma unroll
          for (int e = 0; e < 8; ++e) v[e] = v[e] * rn * g[j * 8 + e];
          float o[8];
#pragma unroll
          for (int e = 0; e < 8; ++e) {
            const float pv = shx(v[e], 2, lane);
            const float rot = (j & 2) ? (v[e] * cs[e] + pv * sn[e]) : (v[e] * cs[e] - pv * sn[e]);
            o[e] = isc ? v[e] : rot;
            if (qk == 0) o[e] *= QSCALE;
          }
          *(uint4*)(pr + qk * 512 + lane * 8) = pack8(o);
        }
        {
          float v[8];
          unpack8(ru_, v);
#pragma unroll
          for (int e = 0; e < 8; ++e) v[e] = gelu_f(v[e]);
          *(uint4*)(pr + 1536 + lane * 8) = pack8(v);
        }
        {
          float v[8];
          unpack8(rv_, v);
          float s = 0.f;
#pragma unroll
          for (int e = 0; e < 8; ++e) { v[e] = gelu_f(v[e]); s += v[e]; }
          const float mean = wave_sum(s) * (1.0f / 512.0f);
          float q = 0.f;
#pragma unroll
          for (int e = 0; e < 8; ++e) { v[e] -= mean; q += v[e] * v[e]; }
          const float rn = rsqrtf(wave_sum(q) * (1.0f / 512.0f) + EPS);
#pragma unroll
          for (int e = 0; e < 8; ++e) v[e] = v[e] * rn * lng[lane * 8 + e];
          *(uint4*)(pr + 2048 + lane * 8) = pack8(v);
        }
      } else if (it < NA + NBt) {
        const int j = it - NA; const int h = j & 3, kb = (j >> 2) % 68, b = j / (4 * 68);
        bf16* T = (bf16*)smem;
#pragma unroll
        for (int i = 0; i < 4; ++i) {
          int cc = tid + i * 256; int key = cc >> 4, part = cc & 15;
          *(uint4*)(T + key * 136 + part * 8) = *(const uint4*)(P + (size_t)key_row(b, kb, key) * INC + 1024 + h * 128 + part * 8);
        }
        __syncthreads();
        bf16* VT = (bf16*)(ws + OFF_VT);
#pragma unroll
        for (int i = 0; i < 4; ++i) {
          int cc = tid + i * 256; int dv = cc >> 3, part = cc & 7;
          uint4 u;
          u.x = (unsigned)T[(part * 8 + 0) * 136 + dv] | ((unsigned)T[(part * 8 + 1) * 136 + dv] << 16);
          u.y = (unsigned)T[(part * 8 + 2) * 136 + dv] | ((unsigned)T[(part * 8 + 3) * 136 + dv] << 16);
          u.z = (unsigned)T[(part * 8 + 4) * 136 + dv] | ((unsigned)T[(part * 8 + 5) * 136 + dv] << 16);
          u.w = (unsigned)T[(part * 8 + 6) * 136 + dv] | ((unsigned)T[(part * 8 + 7) * 136 + dv] << 16);
          *(uint4*)(VT + ((size_t)(b * 4 + h) * 128 + dv) * LK + kb * 64 + part * 8) = u;
        }
        __syncthreads();
      } else {
        const int j = it - NA - NBt;
        f32x4 acc[4][4];
        ACC_ZERO(acc)
        if (j < NB * 4 * 2 * 32) {
          const int jj = j & 31, ri = (j >> 5) & 1, g = (j >> 6) & 3, b = j >> 8;
          gemm_tile<128, 128, false>(P + (size_t)(b * SEQ + 2 * jj) * INC + 2560 + g * 128, (long)64 * INC,
                                     (const bf16*)(ws + OFF_FC) + (size_t)ri * 128 * 128, 128, 128, acc, smem, INC);
          bf16* ys = (bf16*)(ws + OFF_YS);
          const int wm_ = wave >> 1, wn_ = wave & 1;
          const int t2 = 2 * jj + wm_;
#pragma unroll
          for (int mi = 0; mi < 4; ++mi)
#pragma unroll
            for (int ni = 0; ni < 4; ++ni) {
              const int t1 = mi * 16 + (lane >> 4) * 4;
              const int kk = wn_ * 64 + ni * 16 + (lane & 15);
              uint2 u; u.x = pk2(acc[mi][ni][0], acc[mi][ni][1]); u.y = pk2(acc[mi][ni][2], acc[mi][ni][3]);
              *(uint2*)(ys + ((((size_t)(b * 4 + g) * 64 + t2) * 128 + kk) * 2 + ri) * 64 + t1) = u;
            }
        } else {
          const int jc = j - NB * 4 * 2 * 32; const int ri = jc & 1, g = (jc >> 1) & 3, mtc = jc >> 3;
          const int r0 = NLAT + mtc * 128;
          gemm_tile<128, 128, false>(P + (size_t)r0 * INC + 2560 + g * 128, INC,
                                     (const bf16*)(ws + OFF_FC) + (size_t)ri * 128 * 128, 128, 128, acc, smem);
          const int b = (r0 - NLAT) / LC, t0 = (r0 - NLAT) % LC;
          bf16* yt = (bf16*)(ws + OFF_YTC) + ((size_t)((b * 4 + g) * 2 + ri) * 128) * LC + t0;
          const int wm_ = wave >> 1, wn_ = wave & 1;
#pragma unroll
          for (int mi = 0; mi < 4; ++mi)
#pragma unroll
            for (int ni = 0; ni < 4; ++ni) {
              const int row = wm_ * 64 + mi * 16 + (lane >> 4) * 4;
              const int col = wn_ * 64 + ni * 16 + (lane & 15);
              uint2 u; u.x = pk2(acc[mi][ni][0], acc[mi][ni][1]); u.y = pk2(acc[mi][ni][2], acc[mi][ni][3]);
              *(uint2*)(yt + (size_t)col * LC + row) = u;
            }
        }
      }
    }
    return;
  }
  if constexpr (KIND == 5) {
    bf16* BR = (bf16*)(ws + OFF_BR);
    constexpr int N_AL = NB * 4 * 32, N_DL = NB * 4 * 64, N_CG = MT * 4, N_AC = NB * 4 * 2, N_DC = NB * 4 * 2;
    for (int it = bid; it < N_AL + (MTL == MT ? N_AC : 0); it += G) {
      int b, h, q0, nkb;
      if (it < N_AL) { const int qb = it & 31; h = (it >> 5) & 3; b = it >> 7; q0 = b * SEQ + qb * 128; nkb = 68; }
      else { const int j = it - N_AL; const int qb = j & 1; h = (j >> 1) & 3; b = j >> 3; q0 = NLAT + b * LC + qb * 128; nkb = 4; }
      attn_item(p, layer, b, h, q0, nkb, smem);
    }
#ifndef DBG_ATTN_ONLY
    for (int it = bid; it < N_DL + (MTL == MT ? N_DC : 0); it += G) {
      f32x4 acc[4][4];
      ACC_ZERO(acc)
      if (it < N_DL) {
        const int jj = it & 63, g = (it >> 6) & 3, b = it >> 8;
        const bf16* ys = (const bf16*)(ws + OFF_YS) + ((size_t)(b * 4 + g) * 64 * 128 + 2 * jj) * 128;
        gemm_tile<128, 128, false>(ys, (long)128 * 128, (const bf16*)(ws + OFF_M1), 128, 128, acc, smem, 128);
        bf16* a1 = (bf16*)(ws + OFF_A1S);
        const int wm_ = wave >> 1, wn_ = wave & 1;
        const int kk = 2 * jj + wm_;
#pragma unroll
        for (int mi = 0; mi < 4; ++mi)
#pragma unroll
          for (int ni = 0; ni < 4; ++ni) {
            const int t2 = mi * 16 + (lane >> 4) * 4;
            const int n = wn_ * 64 + ni * 16 + (lane & 15); const int rip = n >> 6, s1 = n & 63;
            uint2 u; u.x = pk2(acc[mi][ni][0], acc[mi][ni][1]); u.y = pk2(acc[mi][ni][2], acc[mi][ni][3]);
            *(uint2*)(a1 + ((((size_t)(b * 4 + g) * 64 + s1) * 128 + kk) * 2 + rip) * 64 + t2) = u;
          }
      } else {
        const int j = it - N_DL; const int mt = j & 1, g = (j >> 1) & 3, b = j >> 3;
        const bf16* DM = (const bf16*)(ws + OFF_DC) + (size_t)mt * 128 * 512;
        const bf16* yt = (const bf16*)(ws + OFF_YTC) + (size_t)((b * 4 + g) * 2) * 128 * LC;
        gemm_tile<128, 128, false>(DM, 2 * LC, yt, LC, LC, acc, smem);
        gemm_tile<128, 128, false>(DM + LC, 2 * LC, yt + (size_t)128 * LC, LC, LC, acc, smem);
        bf16* out = BR + (size_t)(NLAT + b * LC + mt * 128) * 1536 + 1024 + g * 128;
        const float nrm = 0.005524271728019903f;
        float* T = (float*)smem;
        STAGE_ACC(acc, T)
        ROW_LOOP(T, {
          float o[8];
_Pragma("unroll")
          for (int e = 0; e < 8; ++e) o[e] = v[e] * nrm;
          *(uint4*)(out + (size_t)row * 1536 + col0) = pack8(o);
        })
      }
    }
    for (int it = bid; it < MTL * 4; it += G) {
      const int g = it & 3, ci = it >> 2;
      f32x4 acc[4][4];
      ACC_ZERO(acc)
      gemm_tile<128, 128, true>((const bf16*)(ws + OFF_WS) + (size_t)(layer * 4 + g) * 128 * 128, 128,
                                P + (size_t)ci * 128 * INC + 2048 + g * 128, INC, 128, acc, smem);
      const float* bs = p.cm_b_s + (layer * 4 + g) * 128;
      const bf16* up = P + (size_t)ci * 128 * INC + 1536 + g * 128;
      bf16* out = BR + (size_t)ci * 128 * 1536 + 512 + g * 128;
      float* T = (float*)smem;
      STAGE_ACC(acc, T)
      ROW_LOOP(T, {
        float uv[8], o[8];
        unpack8(*(const uint4*)(up + (size_t)row * INC + col0), uv);
        const float bsr = bs[row];
_Pragma("unroll")
        for (int e = 0; e < 8; ++e) o[e] = uv[e] * (v[e] + bsr);
        *(uint4*)(out + (size_t)row * 1536 + col0) = pack8(o);
      })
    }
#endif
    return;
  }
  if constexpr (KIND == 12) {
    bf16* BR = (bf16*)(ws + OFF_BR);
    for (int it = bid; it < NB * 4 * 64; it += G) {
      const int s1 = it & 63, g = (it >> 6) & 3, b = it >> 8;
      f32x4 acc[4][4];
      ACC_ZERO(acc)
      gemm_tile<128, 128, false>((const bf16*)(ws + OFF_M2) + (size_t)s1 * 64 * 128, 128,
                                 (const bf16*)(ws + OFF_A1S) + ((size_t)(b * 4 + g) * 64 + s1) * 128 * 128, 128, 128, acc, smem);
      bf16* out = BR + (size_t)(b * SEQ + s1) * 1536 + 1024 + g * 128;
      const float nrm = 0.001381067932004976f;
      float* T = (float*)smem;
      STAGE_ACC(acc, T)
      ROW_LOOP(T, {
        if (row < 64) {
          float o[8];
_Pragma("unroll")
          for (int e = 0; e < 8; ++e) o[e] = v[e] * nrm;
          *(uint4*)(out + (size_t)row * 64 * 1536 + col0) = pack8(o);
        }
      })
    }
    return;
  }
  if constexpr (KIND == 6) {
    const bf16* BR = (const bf16*)(ws + OFF_BR);
    const bf16* W = (const bf16*)(ws + OFF_WBR);
    bf16* ZB = (bf16*)(ws + OFF_ZB);
    DYN_BEGIN(MTL * 8)
      const int mt = it >> 3, nt = it & 7;
      float z[8][8];
#pragma unroll
      for (int i = 0; i < 8; ++i)
#pragma unroll
        for (int e = 0; e < 8; ++e) z[i][e] = 0.f;
      float* T = (float*)smem;
#pragma unroll 1
      for (int n = 0; n < 3; ++n) {
        f32x4 acc[4][4];
        ACC_ZERO(acc)
        gemm_tile<128, 128, false>(BR + (size_t)mt * 128 * 1536 + n * 512, 1536, W + ((size_t)n * D + nt * 128) * 512, 512, 512, acc, smem);
        const bf16* gl = P + (size_t)mt * 128 * INC + 3072 + n * D + nt * 128;
        const float* bg = p.b_gate + (size_t)layer * 3 * D + n * D + nt * 128;
        STAGE_ACC(acc, T)
        ROW_LOOP(T, {
          float gv[8];
          unpack8(*(const uint4*)(gl + (size_t)row * INC + col0), gv);
          const float4 b0 = *(const float4*)(bg + col0), b1 = *(const float4*)(bg + col0 + 4);
          const float bb[8] = {b0.x, b0.y, b0.z, b0.w, b1.x, b1.y, b1.z, b1.w};
_Pragma("unroll")
          for (int e = 0; e < 8; ++e) z[i_][e] += v[e] / (1.0f + __expf(-(gv[e] + bb[e])));
        })
      }
      bf16* out = ZB + (size_t)mt * 128 * D + nt * 128;
      {
        const int tid_r = opaque_tid();
        const int col0 = (tid_r & 15) * 8;
#pragma unroll
        for (int i_ = 0; i_ < 8; ++i_) {
          const int row = (tid_r >> 4) + 16 * i_;
          *(uint4*)(out + (size_t)row * D + col0) = pack8(z[i_]);
        }
      }
    DYN_END()
    return;
  }
  if constexpr (KIND == 7) {
    const bf16* ZB = (const bf16*)(ws + OFF_ZB);
    const bf16* W = (const bf16*)(ws + OFF_WOUT);
    DYN_BEGIN(MTL * 8)
      const int mt = it >> 3, nt = it & 7;
      f32x4 acc[4][4];
      ACC_ZERO(acc)
      gemm_tile_d4(ZB + (size_t)mt * 128 * D, D, W + (size_t)nt * 128 * D, D, D, acc, smem);
      const int r0 = mt * 128;
      const int brow = r0 >= NLAT ? 8 : r0 / SEQ;
      const float* gate = MODL + (size_t)brow * INC + 2 * D + nt * 128;
      float* xo = X + (size_t)r0 * D + nt * 128;
      float* T = (float*)smem;
      STAGE_ACC(acc, T)
      ROW_LOOP(T, {
        float* xp = xo + (size_t)row * D + col0;
        float4 x0 = *(const float4*)xp, x1 = *(const float4*)(xp + 4);
        const float4 g0 = *(const float4*)(gate + col0), g1 = *(const float4*)(gate + col0 + 4);
        x0.x += g0.x * v[0]; x0.y += g0.y * v[1]; x0.z += g0.z * v[2]; x0.w += g0.w * v[3];
        x1.x += g1.x * v[4]; x1.y += g1.y * v[5]; x1.z += g1.z * v[6]; x1.w += g1.w * v[7];
        *(float4*)xp = x0; *(float4*)(xp + 4) = x1;
      })
    DYN_END()
    return;
  }
  if constexpr (KIND == 8) {
    const int NA = MTL * 16; constexpr int NU = 16384 / 8;
    for (int it = bid; it < NA + 2 * NU; it += G) {
      if (it < NA) {
        const int r = it * 8 + wave * 2;
        const int brow = r >= NLAT ? 8 : r / SEQ;
        float v0[16], v1[16];
        load_row_f32(X + (size_t)r * D, lane, v0);
        load_row_f32(X + (size_t)(r + 1) * D, lane, v1);
        const float* m = MODL + (size_t)brow * INC;
        normmod_store(v0, p.norm2_g + layer * D, m + 3 * D, m + 4 * D, HB + (size_t)r * D, lane);
        normmod_store(v1, p.norm2_g + layer * D, m + 3 * D, m + 4 * D, HB + (size_t)(r + 1) * D, lane);
      } else {
        const bool isu = it < NA + NU;
        const int row = (it - NA - (isu ? 0 : NU)) * 8 + wave * 2;
        const float* src = (isu ? p.peer_u : p.peer_v) + ((size_t)layer * 16384 + row) * D;
        unsigned char* dst = (unsigned char*)(ws + (isu ? OFF_U : OFF_V)) + (size_t)row * D;
        float* sc = (float*)(ws + (isu ? OFF_USC : OFF_VSC)) + row;
        conv_fp8_row2(src, dst, sc, lane);
      }
    }
    return;
  }
  if constexpr (KIND == 9) {
    const bf16* W = (const bf16*)(ws + OFF_WQ);
    bf16* QP = (bf16*)(ws + OFF_QP);
    DYN_BEGIN(MTL * 16)
      const int mt = it >> 4, nt = it & 15;
      f32x4 acc[4][4];
      ACC_ZERO(acc)
      gemm_tile_d4(HB + (size_t)mt * 128 * D, D, W + (size_t)nt * 128 * D, D, D, acc, smem);
      bf16* out = QP + (size_t)mt * 128 * 2048 + nt * 128;
      float* T = (float*)smem;
      STAGE_ACC(acc, T)
      ROW_LOOP(T, *(uint4*)(out + (size_t)row * 2048 + col0) = pack8(v);)
    DYN_END()
    return;
  }
  if constexpr (KIND == 10) {
    const bf16* QP = (const bf16*)(ws + OFF_QP);
    int* SELI = (int*)(ws + OFF_SELI);
    float* SELG = (float*)(ws + OFF_SELG);
    const int nconv = (layer + 1 < DEPTH) ? CONV_ITEMS : 0;
    DYN_BEGIN(MTL * 8 + nconv)
      if (it >= MTL * 8) { conv_layer_item(p, layer + 1, it - MTL * 8, smem); } else {
      const int mt = it >> 3, h = it & 7;
#if SELFCHECK
      for (int rep = 0; rep < 2; ++rep) {
#endif
      float s1[16], s2[16]; int i1[16], i2[16];
      peer_list(QP + (size_t)mt * 128 * 2048 + (h * 2 + 0) * 128, (const bf16*)(ws + OFF_KEYS) + (size_t)((layer * 8 + h) * 2 + 0) * 128 * 128, smem, s1, i1);
      peer_list(QP + (size_t)mt * 128 * 2048 + (h * 2 + 1) * 128, (const bf16*)(ws + OFF_KEYS) + (size_t)((layer * 8 + h) * 2 + 1) * 128 * 128, smem, s2, i2);
      if (tid < 128) {
        float tv[16]; int ti[16];
#pragma unroll
        for (int j = 0; j < 16; ++j) { tv[j] = -INFINITY; ti[j] = 0; }
#pragma unroll
        for (int a = 0; a < 16; ++a)
#pragma unroll
          for (int b2 = 0; b2 < 16; ++b2)
            if ((a + 1) * (b2 + 1) <= 16) TK_INS2(tv, ti, s1[a] + s2[b2], i1[a] * 128 + i2[b2])
        float e[16], sum = 0.f;
#pragma unroll
        for (int j = 0; j < 16; ++j) { e[j] = __expf(tv[j] - tv[0]); sum += e[j]; }
        const float inv = 1.0f / sum;
        const size_t o = ((size_t)(mt * 128 + tid) * 8 + h) * 16;
#if SELFCHECK
        if (rep == 1) {
          bool bad = false;
#pragma unroll
          for (int j = 0; j < 16; ++j) bad |= (SELI[o + j] != ti[j]) || (__float_as_uint(SELG[o + j]) != __float_as_uint(e[j] * inv));
          if (bad) atomicOr((unsigned*)(ws + OFF_BAR) + 8, 1u);
        }
#endif
#pragma unroll
        for (int j = 0; j < 16; j += 4) {
          *(int4*)(SELI + o + j) = make_int4(ti[j], ti[j + 1], ti[j + 2], ti[j + 3]);
          *(float4*)(SELG + o + j) = make_float4(e[j] * inv, e[j + 1] * inv, e[j + 2] * inv, e[j + 3] * inv);
        }
      }
      __syncthreads();
#if SELFCHECK
      }
#endif
      }
    DYN_END()
    return;
  }
  if constexpr (KIND == 11) {
    const unsigned char* U8 = (const unsigned char*)(ws + OFF_U);
    const unsigned char* V8 = (const unsigned char*)(ws + OFF_V);
    const float* USC = (const float*)(ws + OFF_USC);
    const float* VSC = (const float*)(ws + OFF_VSC);
    const int* SELI = (const int*)(ws + OFF_SELI);
    const float* SELG = (const float*)(ws + OFF_SELG);
    const bool last = layer == DEPTH - 1;
    const int nrows = last ? NLAT : MROWS;
    for (int it = bid; it < nrows / 4; it += G) {
      const int r = it * 4 + wave;
      const int brow = r >= NLAT ? 8 : r / SEQ;
      float hv[16], o[16];
      unpack8(*(const uint4*)(HB + (size_t)r * D + lane * 16), hv);
      unpack8(*(const uint4*)(HB + (size_t)r * D + lane * 16 + 8), hv + 8);
      float xv[16], g2[16];
      load_row16_f32(X + (size_t)r * D, lane, xv);
      load_row16_f32(MODL + (size_t)brow * INC + 5 * D, lane, g2);
#pragma unroll
      for (int e = 0; e < 16; ++e) o[e] = 0.f;
      const int idA = SELI[(size_t)r * 128 + lane], idB = SELI[(size_t)r * 128 + 64 + lane];
      const float gA = SELG[(size_t)r * 128 + lane], gB = SELG[(size_t)r * 128 + 64 + lane];
      const float usA = USC[idA], usB = USC[idB], vsA = VSC[idA], vsB = VSC[idB];
      const int sub4 = (lane >> 4) & 3;
      u32x4 uqa[4], vqa[4], uqb[4], vqb[4];
#define PG_LOAD(uq, vq, gi)                                                                   \
  {                                                                                           \
    const int idr_ = (gi) < 16 ? idA : idB;                                                   \
    _Pragma("unroll") for (int j = 0; j < 4; ++j) {                                           \
      const int e_ = __builtin_amdgcn_readlane(idr_, (((gi) & 15) << 2) + j);                 \
      uq[j] = *(const u32x4*)(U8 + (size_t)e_ * D + lane * 16);                               \
      vq[j] = *(const u32x4*)(V8 + (size_t)e_ * D + lane * 16);                               \
    }                                                                                         \
  }
#define PG_COMPUTE(uq, vq, gi)                                                                \
  {                                                                                           \
    const float d0 = dot16_fp8(uq[0], hv), d1 = dot16_fp8(uq[1], hv), d2 = dot16_fp8(uq[2], hv), d3 = dot16_fp8(uq[3], hv); \
                  \
    const bool b5 = lane & 32, b4 = lane & 16;                                                \
    float k0 = b5 ? d2 : d0, k1 = b5 ? d3 : d1;                                               \
    k0 += shx(b5 ? d0 : d2, 32, lane); k1 += shx(b5 ? d1 : d3, 32, lane);                  \
    float dd = b4 ? k1 : k0;                                                                  \
    dd += shx(b4 ? k0 : k1, 16, lane);                                                       \
    dd += shx(dd, 8, lane); dd += shx(dd, 4, lane); dd += shx(dd, 2, lane); dd += shx(dd, 1, lane); \
    const int src_ = (((gi) & 15) << 2) + sub4;                                               \
    const float us_ = shl((gi) < 16 ? usA : usB, src_, lane), vs_ = shl((gi) < 16 ? vsA : vsB, src_, lane); \
    const float gg_ = shl((gi) < 16 ? gA : gB, src_, lane);                                      \
    const float w_ = gg_ * gelu_f(dd * us_) * vs_;                                            \
    _Pragma("unroll") for (int j = 0; j < 4; ++j) {                                           \
      const float wj = __uint_as_float(__builtin_amdgcn_readlane(__float_as_uint(w_), j * 16)); \
      axpy16_fp8(vq[j], wj, o);                                                               \
    }                                                                                         \
  }
      PG_LOAD(uqa, vqa, 0)
#pragma unroll 1
      for (int gi = 0; gi < 32; gi += 2) {
        __builtin_amdgcn_sched_barrier(0);
        PG_LOAD(uqb, vqb, gi + 1)
        __builtin_amdgcn_sched_barrier(0);
        PG_COMPUTE(uqa, vqa, gi)
        __builtin_amdgcn_sched_barrier(0);
        if (gi + 2 < 32) PG_LOAD(uqa, vqa, gi + 2)
        __builtin_amdgcn_sched_barrier(0);
        PG_COMPUTE(uqb, vqb, gi + 1)
        __builtin_amdgcn_sched_barrier(0);
      }
#undef PG_LOAD
#undef PG_COMPUTE
#pragma unroll
      for (int e = 0; e < 16; ++e) xv[e] += g2[e] * o[e];
      if (last) {
#if SELFCHECK
        if (__hip_atomic_load((unsigned*)(ws + OFF_BAR) + 8, __ATOMIC_RELAXED, __HIP_MEMORY_SCOPE_AGENT) != 0u) xv[0] = __uint_as_float(0x7fc00000u);
#endif
        store_row16_f32(p.out + (size_t)r * D, lane, xv);
      } else {
        store_row16_f32(X + (size_t)r * D, lane, xv);
        const float* m = MOD + (size_t)((layer + 1) * 9 + brow) * INC;
        normmod_store16(xv, p.norm1_g + (layer + 1) * D, m, m + D, HB + (size_t)r * D, lane);
      }
    }
    return;
  }
}

DI void run_phase(const Params& p, int ph, char* smem) {
  if (ph == 0) { phase_body<0>(p, 0, smem); return; }
  if (ph == 1) { phase_body<1>(p, 0, smem); return; }
  if (ph == 2) { phase_body<2>(p, 0, smem); return; }
  const int layer = (ph - 3) / 10, sub = (ph - 3) % 10;
  switch (sub) {
    case 0: phase_body<3>(p, layer, smem); break;
    case 1: phase_body<4>(p, layer, smem); break;
    case 2: phase_body<5>(p, layer, smem); break;
    case 3: phase_body<12>(p, layer, smem); break;
    case 4: phase_body<6>(p, layer, smem); break;
    case 5: phase_body<7>(p, layer, smem); break;
    case 6: phase_body<8>(p, layer, smem); break;
    case 7: phase_body<9>(p, layer, smem); break;
    case 8: phase_body<10>(p, layer, smem); break;
    default: phase_body<11>(p, layer, smem); break;
  }
}

#ifndef SYNC_CG
#define SYNC_CG 0
#endif
#ifndef PROBE_KIND
#define PROBE_KIND -1
#endif
#if USE_COOP
__global__ void __launch_bounds__(256, 2) fwd_kernel(Params p, int ph_lo, int ph_hi) {
  extern __shared__ __attribute__((aligned(16))) char smem[];
  volatile LAS unsigned* st = (volatile LAS unsigned*)(smem + LDS_BYTES);
  if (threadIdx.x == 0) { st[0] = 0u; st[1] = 0u; st[2] = 0u; st[3] = 0u; }
  __syncthreads();
  const XcdBarrier bar = xcd_barrier_post((unsigned*)(p.ws + OFF_BAR), st);
  cg::this_grid().sync();
  for (int ph = ph_lo; ph < ph_hi; ++ph) {
    run_phase(p, ph, smem);
#if PROBE_KIND >= 0
    {
      const int sub_ = (ph - 3) % 10, layer_ = (ph - 3) / 10;
      const int kind_ = sub_ == 0 ? 3 : sub_ == 1 ? 4 : sub_ == 2 ? 5 : sub_ == 3 ? 12 : sub_ + 2;
      bool rep = ph >= 3 && kind_ == PROBE_KIND;
      if (PROBE_KIND == 11) rep = rep && layer_ == DEPTH - 1;
      if (rep) { xcd_barrier(bar); run_phase(p, ph, smem); }
    }
#endif
    if (ph + 1 < ph_hi) {
#if SYNC_CG
      cg::this_grid().sync();
#else
      xcd_barrier(bar);
#endif
    }
  }
}
#else
template <int KIND>
__global__ void __launch_bounds__(256, 2) phase_kernel(Params p, int layer) {
  extern __shared__ __attribute__((aligned(16))) char smem[];
  phase_body<KIND>(p, layer, smem);
}
template <int KIND>
static void launch_phase(const Params& p, int layer, int grid, hipStream_t stream) {
  static bool attr = false;
  if (!attr) { (void)hipFuncSetAttribute((const void*)phase_kernel<KIND>, hipFuncAttributeMaxDynamicSharedMemorySize, LDS_BYTES); attr = true; }
  hipLaunchKernelGGL(phase_kernel<KIND>, dim3(grid), dim3(256), LDS_BYTES, stream, p, layer);
}
#endif

extern "C" void kernel_launch(void* const* d_in, const int* in_sizes, int n_in, void* d_out, int out_size, void* d_ws,
                              size_t ws_size, hipStream_t stream) {
  static int grid = 0;
  if (grid == 0) {
    if (ws_size < WS_END) { fprintf(stderr, "kernel_launch: workspace too small: need %zu have %zu\n", (size_t)WS_END, ws_size); grid = -1; return; }
    int dev = 0, cus = 0, per_cu = 0;
    (void)hipGetDevice(&dev);
    (void)hipDeviceGetAttribute(&cus, hipDeviceAttributeMultiprocessorCount, dev);
#if USE_COOP
    (void)hipFuncSetAttribute((const void*)fwd_kernel, hipFuncAttributeMaxDynamicSharedMemorySize, LDS_BYTES + 16);
    (void)hipOccupancyMaxActiveBlocksPerMultiprocessor(&per_cu, (const void*)fwd_kernel, 256, LDS_BYTES + 16);
    if (per_cu < 1) per_cu = 1;
    if (per_cu > 2) per_cu = 2;
#else
    per_cu = 2;
#endif
    if (cus < 1) cus = 256;
    grid = cus * per_cu;
    (void)hipGetLastError();
  }
  if (grid < 0) return;
  Params p{};
  const float** pf = (const float**)&p;
  for (int i = 0; i < 23; ++i) pf[i] = (const float*)d_in[i];
  p.out = (float*)d_out;
  p.ws = (char*)d_ws;
#if USE_COOP
  int lo = 0, hi = N_PHASES;
  void* args[] = {&p, &lo, &hi};
  (void)hipMemsetAsync((char*)d_ws + OFF_BAR, 0, 16384, stream);
  hipError_t e = hipLaunchCooperativeKernel((const void*)fwd_kernel, dim3(grid), dim3(256), args, LDS_BYTES + 16, stream);
  if (e != hipSuccess) fprintf(stderr, "cooperative launch failed: %s (grid %d)\n", hipGetErrorString(e), grid);
#else
  launch_phase<0>(p, 0, grid, stream);
  launch_phase<1>(p, 0, grid, stream);
  launch_phase<2>(p, 0, grid, stream);
  for (int l = 0; l < DEPTH; ++l) {
    launch_phase<3>(p, l, grid, stream); launch_phase<4>(p, l, grid, stream); launch_phase<5>(p, l, grid, stream); launch_phase<12>(p, l, grid, stream);
    launch_phase<6>(p, l, grid, stream); launch_phase<7>(p, l, grid, stream); launch_phase<8>(p, l, grid, stream);
    launch_phase<9>(p, l, grid, stream); launch_phase<10>(p, l, grid, stream); launch_phase<11>(p, l, grid, stream);
  }
#endif
}
```
